# Optimizing an MI355X kernel written in HIP

```python
import jax, jax.numpy as jnp
from jax import lax
import numpy as np

D_MODEL = 2048
BATCH = 4
SEQ = 2048
DEPTH = 2

CHUNK = 64
N_LEFT_CHUNKS = 8
BAND = (N_LEFT_CHUNKS + 1) * CHUNK
HEAD_DIM = 64
N_HEADS = D_MODEL // HEAD_DIM
D_FF = 4 * D_MODEL
N_A_LAYERS = DEPTH // 2
N_B_LAYERS = DEPTH - N_A_LAYERS
DECAY_LORA = 96
ICLR_LORA = 96
GATE_LORA = 256
REL_CLIP = 256
RMS_EPS = 1e-6
GN_EPS = 64e-5

kernel_name = "rwkv7_yoco_chunk_band_attn_adaln"


def rms_norm(x, g):
    xf = x.astype(jnp.float32)
    y = xf * lax.rsqrt(jnp.mean(xf * xf, axis=-1, keepdims=True) + RMS_EPS)
    return (y * g.astype(jnp.float32)).astype(x.dtype)


def modulate(h, shift, scale):
    return h * (1 + scale[:, None, :]) + shift[:, None, :]


def token_shift(h):
    return jnp.pad(h, ((0, 0), (1, 0), (0, 0)))[:, :-1]


def rwkv7_time_mix(h, mu, w_r, w_k, w_v, w_o, w0, w1, w2, a0, a1, a2,
                   g1, g2, k_k, k_a, r_k, ln_w, ln_b):
    B, T, D = h.shape
    xx = token_shift(h) - h
    xr, xw, xk, xv, xa, xg = [h + xx * mu[j] for j in range(6)]
    r = xr @ w_r
    k = xk @ w_k
    v = xv @ w_v
    w_log = -jax.nn.softplus(-(w0 + jnp.tanh(xw @ w1) @ w2)) - 0.5
    a = jax.nn.sigmoid(a0 + (xa @ a1) @ a2)
    g = jax.nn.sigmoid(xg @ g1) @ g2

    def heads(t):
        return t.reshape(B, T, N_HEADS, HEAD_DIM).astype(jnp.float32)

    kk = heads(k * k_k)
    kk = kk / jnp.maximum(jnp.sqrt(jnp.sum(kk * kk, axis=-1, keepdims=True)), 1e-12)
    k = k * (1 + (a - 1) * k_a)
    r_h, k_h, v_h, a_h = heads(r), heads(k), heads(v), heads(a)
    decay = jnp.exp(-jnp.exp(heads(w_log)))

    def step(S, inp):
        r_t, w_t, k_t, v_t, kk_t, a_t = inp
        sa = jnp.einsum('bhvk,bhk->bhv', S, -kk_t)
        S = (S * w_t[:, :, None, :] + sa[..., None] * (kk_t * a_t)[:, :, None, :]
             + v_t[..., None] * k_t[:, :, None, :])
        y = jnp.einsum('bhvk,bhk->bhv', S, r_t)
        return S, y

    S0 = jnp.zeros((B, N_HEADS, HEAD_DIM, HEAD_DIM), jnp.float32)
    xs = tuple(jnp.moveaxis(t, 1, 0) for t in (r_h, decay, k_h, v_h, kk, a_h))
    _, y = lax.scan(step, S0, xs)
    y = jnp.moveaxis(y, 0, 1)
    mean = jnp.mean(y, axis=-1, keepdims=True)
    var = jnp.mean(jnp.square(y - mean), axis=-1, keepdims=True)
    y = ((y - mean) * lax.rsqrt(var + GN_EPS) * ln_w.reshape(N_HEADS, HEAD_DIM).astype(jnp.float32)
         + ln_b.reshape(N_HEADS, HEAD_DIM).astype(jnp.float32))
    y = y + jnp.sum(r_h * k_h * r_k.astype(jnp.float32), axis=-1, keepdims=True) * v_h
    y = y.reshape(B, T, D).astype(h.dtype) * g
    return y @ w_o


def chunk_band_attention(h, kp, vp, w_q, w_o, rel_bias):
    B, T, D = h.shape
    nc = T // CHUNK
    q = (h @ w_q).reshape(B, nc, CHUNK, N_HEADS, HEAD_DIM)
    q_chunks = jnp.moveaxis(q, 1, 0)
    pad = N_LEFT_CHUNKS * CHUNK
    i = jnp.arange(CHUNK)[:, None]
    j = jnp.arange(BAND)[None, :]
    rel = i + pad - j
    idx = jnp.clip(rel, -REL_CLIP, REL_CLIP) + REL_CLIP
    bias = rel_bias[:, idx].astype(jnp.float32)
    scale = HEAD_DIM ** -0.5

    def one_chunk(args):
        n, q_c = args
        start = n * CHUNK
        k_b = lax.dynamic_slice_in_dim(kp, start, BAND, axis=1)
        v_b = lax.dynamic_slice_in_dim(vp, start, BAND, axis=1)
        s = jnp.einsum('bqhd,bkhd->bhqk', q_c, k_b).astype(jnp.float32) * scale + bias
        valid = (start + jnp.arange(BAND)) >= pad
        s = jnp.where(valid[None, None, None, :], s, -1e30)
        p = jax.nn.softmax(s, axis=-1).astype(v_b.dtype)
        return jnp.einsum('bhqk,bkhd->bqhd', p, v_b)

    o = lax.map(one_chunk, (jnp.arange(nc), q_chunks))
    o = jnp.moveaxis(o, 0, 1).reshape(B, T, D)
    return o @ w_o


def sq_relu_mlp(h, w_up, w_down):
    return jnp.square(jax.nn.relu(h @ w_up)) @ w_down


def setup_inputs(seed: int = 0) -> dict:
    key = jax.random.key(seed)
    ks = iter(jax.random.split(key, 64))
    D = D_MODEL
    nrm = lambda shape, s: jax.random.normal(next(ks), shape, jnp.float32) * s
    nA, nB, L = N_A_LAYERS, N_B_LAYERS, DEPTH
    return {
        "x": nrm((BATCH, SEQ, D), 1.0),
        "c": nrm((BATCH, D), 1.0),
        "w_ada": nrm((L, D, 6 * D), 0.5 * D ** -0.5),
        "b_ada": nrm((L, 6 * D), 0.01),
        "g_mix": 1.0 + nrm((L, D), 0.02),
        "g_mlp": 1.0 + nrm((L, D), 0.02),
        "w_up": nrm((L, D, D_FF), D ** -0.5),
        "w_down": nrm((L, D_FF, D), D_FF ** -0.5),
        "rwkv_mu": jax.random.uniform(next(ks), (nA, 6, D), jnp.float32),
        "rwkv_w_r": nrm((nA, D, D), D ** -0.5),
        "rwkv_w_k": nrm((nA, D, D), D ** -0.5),
        "rwkv_w_v": nrm((nA, D, D), D ** -0.5),
        "rwkv_w_o": nrm((nA, D, D), D ** -0.5),
        "rwkv_w0": -1.0 + nrm((nA, D), 0.5),
        "rwkv_w1": nrm((nA, D, DECAY_LORA), D ** -0.5),
        "rwkv_w2": nrm((nA, DECAY_LORA, D), 0.5 * DECAY_LORA ** -0.5),
        "rwkv_a0": nrm((nA, D), 0.5),
        "rwkv_a1": nrm((nA, D, ICLR_LORA), D ** -0.5),
        "rwkv_a2": nrm((nA, ICLR_LORA, D), 0.5 * ICLR_LORA ** -0.5),
        "rwkv_g1": nrm((nA, D, GATE_LORA), D ** -0.5),
        "rwkv_g2": nrm((nA, GATE_LORA, D), GATE_LORA ** -0.5),
        "rwkv_k_k": 0.85 + nrm((nA, D), 0.05),
        "rwkv_k_a": 1.0 + nrm((nA, D), 0.05),
        "rwkv_r_k": nrm((nA, N_HEADS, HEAD_DIM), 0.1),
        "rwkv_ln_w": 1.0 + nrm((nA, D), 0.02),
        "rwkv_ln_b": nrm((nA, D), 0.01),
        "attn_w_q": nrm((nB, D, D), D ** -0.5),
        "attn_w_o": nrm((nB, D, D), D ** -0.5),
        "attn_rel_bias": nrm((nB, N_HEADS, 2 * REL_CLIP + 1), 0.5),
        "w_ada_kv": nrm((D, 2 * D), 0.5 * D ** -0.5),
        "b_ada_kv": nrm((2 * D,), 0.01),
        "g_kv": 1.0 + nrm((D,), 0.02),
        "w_k_shared": nrm((D, D), D ** -0.5),
        "w_v_shared": nrm((D, D), D ** -0.5),
        "g_final": 1.0 + nrm((D,), 0.02),
    }


def reference(x, c, w_ada, b_ada, g_mix, g_mlp, w_up, w_down,
              rwkv_mu, rwkv_w_r, rwkv_w_k, rwkv_w_v, rwkv_w_o,
              rwkv_w0, rwkv_w1, rwkv_w2, rwkv_a0, rwkv_a1, rwkv_a2,
              rwkv_g1, rwkv_g2, rwkv_k_k, rwkv_k_a, rwkv_r_k, rwkv_ln_w, rwkv_ln_b,
              attn_w_q, attn_w_o, attn_rel_bias,
              w_ada_kv, b_ada_kv, g_kv, w_k_shared, w_v_shared, g_final):
    B, T, D = x.shape
    pad = N_LEFT_CHUNKS * CHUNK
    kp = vp = None
    for layer in range(DEPTH):
        mod = c @ w_ada[layer] + b_ada[layer]
        sh1, sc1, gt1, sh2, sc2, gt2 = jnp.split(mod, 6, axis=-1)
        if layer == N_A_LAYERS:
            sh_kv, sc_kv = jnp.split(c @ w_ada_kv + b_ada_kv, 2, axis=-1)
            h_kv = modulate(rms_norm(x, g_kv), sh_kv, sc_kv)
            k_s = (h_kv @ w_k_shared).reshape(B, T, N_HEADS, HEAD_DIM)
            v_s = (h_kv @ w_v_shared).reshape(B, T, N_HEADS, HEAD_DIM)
            kp = jnp.pad(k_s, ((0, 0), (pad, 0), (0, 0), (0, 0)))
            vp = jnp.pad(v_s, ((0, 0), (pad, 0), (0, 0), (0, 0)))
        h = modulate(rms_norm(x, g_mix[layer]), sh1, sc1)
        if layer < N_A_LAYERS:
            i = layer
            y = rwkv7_time_mix(h, rwkv_mu[i], rwkv_w_r[i], rwkv_w_k[i], rwkv_w_v[i], rwkv_w_o[i],
                               rwkv_w0[i], rwkv_w1[i], rwkv_w2[i], rwkv_a0[i], rwkv_a1[i], rwkv_a2[i],
                               rwkv_g1[i], rwkv_g2[i], rwkv_k_k[i], rwkv_k_a[i], rwkv_r_k[i],
                               rwkv_ln_w[i], rwkv_ln_b[i])
        else:
            i = layer - N_A_LAYERS
            y = chunk_band_attention(h, kp, vp, attn_w_q[i], attn_w_o[i], attn_rel_bias[i])
        x = x + gt1[:, None, :] * y
        h = modulate(rms_norm(x, g_mlp[layer]), sh2, sc2)
        x = x + gt2[:, None, :] * sq_relu_mlp(h, w_up[layer], w_down[layer])
    return rms_norm(x, g_final)
```

```cpp
#include <hip/hip_runtime.h>
#include <hip/hip_cooperative_groups.h>
#include <cstdio>
#include <cstdint>
namespace cg = cooperative_groups;

#define LAS __attribute__((address_space(3)))
typedef unsigned short bf16_t;
typedef short bf16x8 __attribute__((ext_vector_type(8)));
typedef float f32x2 __attribute__((ext_vector_type(2)));
typedef float f32x4 __attribute__((ext_vector_type(4)));
typedef float f32x16 __attribute__((ext_vector_type(16)));
typedef unsigned u32x2 __attribute__((ext_vector_type(2)));
typedef unsigned u32x4 __attribute__((ext_vector_type(4)));

constexpr int DM = 2048, NB = 4, TT = 2048, MTOK = NB * TT, NH = 32, FF = 8192;
constexpr float RMS_EPS = 1e-6f, GN_EPS = 64e-5f;
constexpr float LOG2E = 1.4426950408889634f;
constexpr float QSCALE = 0.125f * LOG2E;
constexpr size_t MD = (size_t)MTOK * DM;

constexpr size_t MiB = 1u << 20;
constexpr size_t WB_RKV = 0;
constexpr size_t WB_L2 = 48 * MiB;
constexpr size_t WB_O = 54 * MiB;
constexpr size_t WB_UP = 62 * MiB;
constexpr size_t WB_DN = 126 * MiB;
constexpr size_t WB_KVQ = 190 * MiB;
constexpr size_t WB_AO = 214 * MiB;
constexpr size_t WS_CTL = 222 * MiB;
constexpr size_t MOD_BYTES = (size_t)(2 * 4 * 12288 + 4 * 4096) * 4;
constexpr size_t WS_BAR = WS_CTL + MOD_BYTES;
constexpr size_t CTL_BYTES = MOD_BYTES + 16384;
constexpr size_t RA = 224 * MiB;
constexpr size_t RB = 416 * MiB;
constexpr size_t RC = 608 * MiB;
constexpr size_t WS_AX6 = RA;
constexpr size_t WS_DEC = RA;
constexpr size_t WS_X1 = RA;
constexpr size_t WS_H2 = RA + 64 * MiB;
constexpr size_t WS_X2 = RA + 96 * MiB;
constexpr size_t WS_X4 = RA + 128 * MiB;
constexpr size_t WS_RKV = RB;
constexpr size_t WS_U = RB;
constexpr size_t WS_KB = RB;
constexpr size_t WS_A2 = RC;
constexpr size_t WS_Y = RC + 8 * MiB;
constexpr size_t WS_BON = RC + 72 * MiB;
constexpr size_t WS_YG = RC + 73 * MiB;
constexpr size_t WS_PARTS = RC + 105 * MiB;
constexpr size_t WS_PART0 = WS_CTL + 512 * 1024;
constexpr size_t WS_END = RC + 107 * MiB;

constexpr int LDS_BYTES = 147456;

__device__ __forceinline__ unsigned cvt_pk_bf16(float lo, float hi) { unsigned r; asm volatile("v_cvt_pk_bf16_f32 %0, %1, %2" : "=v"(r) : "v"(lo), "v"(hi)); return r; }
__device__ __forceinline__ u32x2 pack4(f32x4 v) { u32x2 w; w.x = cvt_pk_bf16(v[0], v[1]); w.y = cvt_pk_bf16(v[2], v[3]); return w; }
template <int CTRL> __device__ __forceinline__ float dppmov(float v) { return __builtin_bit_cast(float, __builtin_amdgcn_update_dpp(0, __builtin_bit_cast(int, v), CTRL, 0xF, 0xF, true)); }
__device__ __forceinline__ float allreduce16(float v) {
    v += dppmov<0xB1>(v); v += dppmov<0x4E>(v); v += dppmov<0x141>(v); v += dppmov<0x140>(v); return v;
}
template <int CTRL> __device__ __forceinline__ float dppmov1(float v) { return __builtin_bit_cast(float, __builtin_amdgcn_update_dpp(0x3f800000, __builtin_bit_cast(int, v), CTRL, 0xF, 0xF, false)); }
__device__ __forceinline__ float scanmul16(float v) { v *= dppmov1<0x111>(v); v *= dppmov1<0x112>(v); v *= dppmov1<0x114>(v); v *= dppmov1<0x118>(v); return v; }
__device__ __forceinline__ float allmul16(float v) { v *= dppmov<0xB1>(v); v *= dppmov<0x4E>(v); v *= dppmov<0x141>(v); v *= dppmov<0x140>(v); return v; }
__device__ __forceinline__ float allreduce64(float v) { v = allreduce16(v); v += __shfl_xor(v, 16); v += __shfl_xor(v, 32); return v; }
__device__ __forceinline__ float fma_s(float a, float b, float c) { float r; asm("v_fma_f32 %0, %1, %2, %3" : "=v"(r) : "v"(a), "v"(b), "v"(c)); return r; }
__device__ __forceinline__ float mul_s(float a, float b) { float r; asm("v_mul_f32 %0, %1, %2" : "=v"(r) : "v"(a), "v"(b)); return r; }
__device__ __forceinline__ float add_s(float a, float b) { float r; asm("v_add_f32 %0, %1, %2" : "=v"(r) : "v"(a), "v"(b)); return r; }
__device__ __forceinline__ f32x4 ldbf4(const bf16_t* p) { const u32x2 w = *(const u32x2*)p; f32x4 r; r[0] = __builtin_bit_cast(float, w.x << 16); r[1] = __builtin_bit_cast(float, w.x & 0xffff0000u); r[2] = __builtin_bit_cast(float, w.y << 16); r[3] = __builtin_bit_cast(float, w.y & 0xffff0000u); return r; }
__device__ __forceinline__ f32x4 cvt4(u32x2 w) { f32x4 r; r[0] = __builtin_bit_cast(float, w.x << 16); r[1] = __builtin_bit_cast(float, w.x & 0xffff0000u); r[2] = __builtin_bit_cast(float, w.y << 16); r[3] = __builtin_bit_cast(float, w.y & 0xffff0000u); return r; }
__device__ __forceinline__ float sum4(f32x4 v) { return (v[0] + v[1]) + (v[2] + v[3]); }
__device__ __forceinline__ float dot4(f32x4 a, f32x4 b) { return (a[0] * b[0] + a[1] * b[1]) + (a[2] * b[2] + a[3] * b[3]); }

__device__ __forceinline__ unsigned char* launder(unsigned char* p) { unsigned lo = (unsigned)(uintptr_t)p, hi = (unsigned)((uintptr_t)p >> 32); asm volatile("" : "+v"(lo), "+v"(hi));
    lo = __builtin_amdgcn_readfirstlane(lo); hi = __builtin_amdgcn_readfirstlane(hi); return (unsigned char*)(__attribute__((address_space(1))) unsigned char*)(((uintptr_t)hi << 32) | (uintptr_t)lo); }
__device__ __forceinline__ int launder_tid() { int t = threadIdx.x; asm volatile("" : "+v"(t)); return t; }

namespace pg8 {
constexpr int BM = 256, BK = 64, HALF = 128, HTB = HALF * BK * 2, STAGE_BYTES = 8 * HTB, NXCD = 8, WGM = 4;
__host__ __device__ __forceinline__ int lds_byte(int r, int c) { const int st = (r >> 4) * 2 + (c >> 5), rr = r & 15, cc = c & 31, ob = rr * 64 + cc * 2; return st * 1024 + (ob ^ (((ob >> 9) & 1) << 5)); }
__host__ __device__ __forceinline__ void stage_rc(int b, int& R, int& C) { const int st = b / 1024, sb = b % 1024, swz = sb ^ (((sb >> 9) & 1) << 5); R = (st >> 1) * 16 + swz / 64; C = (st & 1) * 32 + (swz % 64) / 2; }

struct Unit { int pm, pn, prob, half; const char* A; const char* B; };

__device__ __forceinline__ void tile_order(int nM, int nN, int wgid, int& pm, int& pn) {
    const int nwg = nM * nN; { const int q = nwg / NXCD, r = nwg % NXCD, xcd = wgid % NXCD, off = wgid / NXCD; wgid = (xcd < r ? xcd * (q + 1) : r * (q + 1) + (xcd - r) * q) + off; }
    const int nig = WGM * nN, gid = wgid / nig, fm = gid * WGM, gsz = (nM - fm) < WGM ? (nM - fm) : WGM;
    pm = fm + ((wgid % nig) % gsz); pn = (wgid % nig) / gsz;
}

template <class Epi, class Sched>
__device__ __forceinline__ void gemm_phase(LAS unsigned char* lds, const int K, const int ld, const Sched& S, const Epi& E) {
    const int tid = launder_tid(), wid = __builtin_amdgcn_readfirstlane(tid >> 6), lane = tid & 63, wr = wid >> 2, wc = wid & 3; int fr = lane & 15, fq = lane >> 4;
    const int nt = K / BK;
    unsigned voffA[2], voffB[2];
#pragma unroll
    for (int i = 0; i < 2; ++i) { int R, C; stage_rc(tid * 16 + i * 8192, R, C); const int rho = R & 31, Rb = (R & ~31) + 8 * ((rho & 15) >> 2) + 4 * (rho >> 4) + (rho & 3);
        voffA[i] = (unsigned)(R * ld + C) * 2u; voffB[i] = (unsigned)(Rb * ld + C) * 2u; }
    const size_t kstep = (size_t)(BK * 2);
    const size_t hstep = (size_t)HALF * ld * 2;
    const unsigned ldsw = (unsigned)wid * 1024u;
    const int aoff = lds_byte(wr * 64 + fr, fq * 8), boff = lds_byte(wc * 32 + fr, fq * 8);
#define PG8_SA(b, h) (((b) * 2 + (h)) * HTB)
#define PG8_SB(b, h) ((4 + (b) * 2 + (h)) * HTB)
#define PG8_STAGE(bufoff, gbase, voff) do { _Pragma("unroll") for (int _i = 0; _i < 2; ++_i) \
        __builtin_amdgcn_global_load_lds((const unsigned*)((const char*)(gbase) + (voff)[_i]), (LAS unsigned*)(lds + (bufoff) + ldsw + _i * 8192), 16, 0, 0); } while (0)
#define PG8_LDA(dst, b, h) do { _Pragma("unroll") for (int m = 0; m < 4; ++m) _Pragma("unroll") for (int k = 0; k < 2; ++k) dst[m][k] = *(const LAS bf16x8*)(lds + PG8_SA(b, h) + aoff + m * 2048 + k * 1024); } while (0)
#define PG8_LDB(dst, b, h) do { _Pragma("unroll") for (int n = 0; n < 2; ++n) _Pragma("unroll") for (int k = 0; k < 2; ++k) dst[n][k] = *(const LAS bf16x8*)(lds + PG8_SB(b, h) + boff + n * 2048 + k * 1024); } while (0)
#define PG8_MMA(ai, bj, At, Bt) do { __builtin_amdgcn_s_setprio(1); _Pragma("unroll") for (int m = 0; m < 4; ++m) _Pragma("unroll") for (int n = 0; n < 2; ++n) _Pragma("unroll") for (int k = 0; k < 2; ++k) \
        acc[ai][bj][m][n] = __builtin_amdgcn_mfma_f32_16x16x32_bf16(Bt[n][k], At[m][k], acc[ai][bj][m][n], 0, 0, 0); __builtin_amdgcn_s_setprio(0); } while (0)
#define PG8_WAIT_V(n) asm volatile("s_waitcnt vmcnt(" #n ")" ::: "memory")
#define PG8_WAIT_L(n) asm volatile("s_waitcnt lgkmcnt(" #n ")" ::: "memory")
#define PG8_BAR __builtin_amdgcn_s_barrier()
#define PG8_SCHED __builtin_amdgcn_sched_barrier(0)
    Unit cur, nxt; int ui = 0;
    if (!S.next(0, cur)) return;
    f32x4 acc[2][2][4][2];
#pragma unroll
    for (int a = 0; a < 2; ++a)
#pragma unroll
        for (int b = 0; b < 2; ++b)
#pragma unroll
            for (int m = 0; m < 4; ++m)
#pragma unroll
                for (int n = 0; n < 2; ++n) acc[a][b][m][n] = (f32x4){0.f, 0.f, 0.f, 0.f};
    bf16x8 At[4][2], B0[2][2], B1[2][2];
    const char* cA = cur.A; const char* cB = cur.B;
    PG8_STAGE(PG8_SB(0, 0), cB, voffB); PG8_STAGE(PG8_SB(0, 1), cB + hstep, voffB); PG8_STAGE(PG8_SA(0, 0), cA, voffA); PG8_STAGE(PG8_SA(0, 1), cA + hstep, voffA);
    if (wr == 1) PG8_BAR;
    PG8_WAIT_V(2); PG8_BAR;
    PG8_STAGE(PG8_SB(1, 0), cB + kstep, voffB); PG8_STAGE(PG8_SA(1, 0), cA + kstep, voffA); PG8_STAGE(PG8_SB(1, 1), cB + hstep + kstep, voffB);
    PG8_WAIT_V(6); PG8_BAR;
    for (;;) {
        const bool has_next = S.next(ui + 1, nxt); const bool full = cur.half == 0;
        const char* nA = has_next ? nxt.A : cA; const char* nB = has_next ? nxt.B : cB;
        for (int t = 0; t < nt; t += 2) {
            const bool last = (t == nt - 2);
            const char* a1 = cA + (size_t)(t + 1) * kstep;
            const char* a2 = last ? nA : cA + (size_t)(t + 2) * kstep; const char* b2 = last ? nB : cB + (size_t)(t + 2) * kstep;
            const char* a3 = a2 + kstep; const char* b3 = b2 + kstep;
            PG8_LDB(B0, 0, 0); PG8_LDB(B1, 0, 1); PG8_SCHED; PG8_LDA(At, 0, 0); PG8_STAGE(PG8_SA(1, 1), a1 + hstep, voffA);
            PG8_WAIT_V(8); PG8_WAIT_L(0); PG8_BAR; PG8_MMA(0, 0, At, B0); if (full) PG8_MMA(0, 1, At, B1); PG8_BAR; PG8_SCHED;
            PG8_LDA(At, 0, 1); PG8_STAGE(PG8_SB(0, 0), b2, voffB); PG8_STAGE(PG8_SB(0, 1), b2 + hstep, voffB); PG8_STAGE(PG8_SA(0, 0), a2, voffA);
            PG8_WAIT_V(8); PG8_WAIT_L(0); PG8_BAR; PG8_MMA(1, 0, At, B0); if (full) PG8_MMA(1, 1, At, B1); PG8_BAR; PG8_SCHED;
            PG8_LDB(B0, 1, 0); PG8_LDB(B1, 1, 1); PG8_SCHED; PG8_LDA(At, 1, 0); PG8_STAGE(PG8_SA(0, 1), a2 + hstep, voffA);
            PG8_WAIT_V(8); PG8_WAIT_L(0); PG8_BAR; PG8_MMA(0, 0, At, B0); if (full) PG8_MMA(0, 1, At, B1); PG8_BAR; PG8_SCHED;
            PG8_LDA(At, 1, 1); PG8_STAGE(PG8_SB(1, 0), b3, voffB); PG8_STAGE(PG8_SB(1, 1), b3 + hstep, voffB); PG8_STAGE(PG8_SA(1, 0), a3, voffA);
            PG8_WAIT_V(8); PG8_WAIT_L(0); PG8_BAR; PG8_MMA(1, 0, At, B0); if (full) PG8_MMA(1, 1, At, B1); PG8_BAR; PG8_SCHED;
        }
        if (wr == 0) PG8_BAR;
        E(acc, cur, wr, wc, fr, fq);
#ifdef EPI2
        E(acc, cur, wr, wc, fr, fq);
#endif
        if (!has_next) break;
#pragma unroll
        for (int a = 0; a < 2; ++a)
#pragma unroll
            for (int b = 0; b < 2; ++b)
#pragma unroll
                for (int m = 0; m < 4; ++m)
#pragma unroll
                    for (int n = 0; n < 2; ++n) acc[a][b][m][n] = (f32x4){0.f, 0.f, 0.f, 0.f};
        cur = nxt; cA = nA; cB = nB; ++ui;
        if (wr == 1) PG8_BAR;
    }
    PG8_WAIT_V(0);
    PG8_BAR;
#undef PG8_SA
#undef PG8_SB
#undef PG8_STAGE
#undef PG8_LDA
#undef PG8_LDB
#undef PG8_MMA
#undef PG8_WAIT_V
#undef PG8_WAIT_L
#undef PG8_BAR
#undef PG8_SCHED
}
}
using pg8::Unit;

struct SchedSimple {
    const char* A; const char* Bt; int nM, nN; size_t tstep; int G, c;
    __device__ __forceinline__ bool next(int i, Unit& u) const {
        const int L = i * G + c; if (L >= nM * nN) return false;
        pg8::tile_order(nM, nN, L, u.pm, u.pn); u.prob = 0; u.half = 0; u.A = A + (size_t)u.pm * tstep; u.B = Bt + (size_t)u.pn * tstep; return true;
    }
};
struct SchedP2 {
    const char* A0; const char* B0; int G, c;
    __device__ __forceinline__ bool next(int i, Unit& u) const {
        const int L = i * G + c; if (L >= 896) return false;
        const size_t tstep = (size_t)256 * DM * 2;
        if (L < 768) { u.prob = L >> 8; u.half = 0; pg8::tile_order(32, 8, L & 255, u.pm, u.pn); u.A = A0 + (size_t)u.prob * (MD * 2) + (size_t)u.pm * tstep; u.B = B0 + (size_t)u.prob * (8 * MiB) + (size_t)u.pn * tstep; }
        else { const int l = L - 768; u.prob = 3 + (l >> 5); u.half = 1; u.pm = l & 31; u.pn = 0; const int slot = u.prob > 5 ? 5 : u.prob;
            u.A = A0 + (size_t)slot * (MD * 2) + (size_t)u.pm * tstep; u.B = B0 + (size_t)slot * (8 * MiB) + (u.prob == 6 ? (size_t)128 * DM * 2 : 0); }
        return true;
    }
};
struct SchedP11 {
    const char* HKV; const char* HQ; const char* W; int G, c;
    __device__ __forceinline__ bool next(int i, Unit& u) const {
        const int L = i * G + c; if (L >= 768) return false;
        const size_t tstep = (size_t)256 * DM * 2;
        u.prob = L >> 8; u.half = 0;
        if (u.prob == 1) { pg8::tile_order(8, 32, L & 255, u.pm, u.pn); u.A = W + 8 * MiB + (size_t)u.pm * tstep; u.B = HKV + (size_t)u.pn * tstep; }
        else { pg8::tile_order(32, 8, L & 255, u.pm, u.pn); u.A = (u.prob == 0 ? HKV : HQ) + (size_t)u.pm * tstep; u.B = W + (size_t)u.prob * (8 * MiB) + (size_t)u.pn * tstep; }
        return true;
    }
};

#define EPI_LOOP_BEGIN(LD) asm volatile("" : "+v"(fr), "+v"(fq)); _Pragma("unroll") for (int ai = 0; ai < 2; ++ai) _Pragma("unroll") for (int m = 0; m < 4; ++m) { const unsigned ro = (unsigned)(ai * 128 + wr * 64 + m * 16 + fr) * (unsigned)(LD); \
    _Pragma("unroll") for (int bj = 0; bj < 2; ++bj) { const int cl = bj * 128 + wc * 32 + fq * 8; const unsigned off = ro + (unsigned)cl; const f32x4 v0 = acc[ai][bj][m][0], v1 = acc[ai][bj][m][1];
#define EPI_LOOP_END } asm volatile("" ::: "memory"); }
__device__ __forceinline__ u32x4 pack8(f32x4 a, f32x4 b) { u32x4 w; w.x = cvt_pk_bf16(a[0], a[1]); w.y = cvt_pk_bf16(a[2], a[3]); w.z = cvt_pk_bf16(b[0], b[1]); w.w = cvt_pk_bf16(b[2], b[3]); return w; }
__device__ __forceinline__ void ldbf8(const bf16_t* p, f32x4& a, f32x4& b) { const u32x4 w = *(const u32x4*)p; a = cvt4((u32x2){w.x, w.y}); b = cvt4((u32x2){w.z, w.w}); }
__device__ __forceinline__ f32x4 sig4(f32x4 x) { f32x4 o;
#pragma unroll
    for (int j = 0; j < 4; ++j) o[j] = 1.0f / (1.0f + __expf(-x[j]));
    return o; }

struct EpiP2 {
    bf16_t* RKV; bf16_t* A2;
    __device__ __forceinline__ void operator()(const f32x4 (&acc)[2][2][4][2], const Unit& u, int wr, int wc, int fr, int fq) const {
        if (u.prob < 3) {
            bf16_t* O = RKV + (size_t)u.prob * MD + (size_t)(u.pm * 256) * DM + u.pn * 256;
            EPI_LOOP_BEGIN(DM) *(u32x4*)(O + off) = pack8(v0, v1); EPI_LOOP_END
        } else if (u.prob == 3) {
            bf16_t* O = A2 + (size_t)(u.pm * 256) * 512;
            EPI_LOOP_BEGIN(512) if (cl < 96) { f32x4 o0, o1;
#pragma unroll
                for (int j = 0; j < 4; ++j) { const float e0 = __expf(2.0f * v0[j]), e1 = __expf(2.0f * v1[j]); o0[j] = 1.0f - 2.0f / (e0 + 1.0f); o1[j] = 1.0f - 2.0f / (e1 + 1.0f); }
                *(u32x4*)(O + off) = pack8(o0, o1); } EPI_LOOP_END
        } else if (u.prob == 4) {
            bf16_t* O = A2 + (size_t)(u.pm * 256) * 512 + 96;
            EPI_LOOP_BEGIN(512) if (cl < 96) { *(u32x4*)(O + off) = pack8(v0, v1); } EPI_LOOP_END
        } else {
            bf16_t* O = A2 + (size_t)(u.pm * 256) * 512 + (u.prob == 5 ? 192 : 320);
            EPI_LOOP_BEGIN(512) if (cl < 128) { *(u32x4*)(O + off) = pack8(sig4(v0), sig4(v1)); } EPI_LOOP_END
        }
    }
};
struct EpiP3 {
    float* DEC; const float* w0; const float* a0; int kind;
    __device__ __forceinline__ void operator()(const f32x4 (&acc)[2][2][4][2], const Unit& u, int wr, int wc, int fr, int fq) const {
        const int cb = u.pn * 256;
        float* O = DEC + (size_t)(u.pm * 256) * DM + cb;
        bf16_t* Ob = (bf16_t*)(DEC + MD) + (size_t)(kind - 1) * MD + (size_t)(u.pm * 256) * DM + cb;
        if (kind == 0) {
            const float* wb = w0 + cb;
            asm volatile("" : "+v"(fr), "+v"(fq));
#pragma unroll
            for (int ai = 0; ai < 2; ++ai)
#pragma unroll
                for (int bj = 0; bj < 2; ++bj) { const int cl = bj * 128 + wc * 32 + fq * 8; const f32x4 wq0 = *(const f32x4*)(wb + cl), wq1 = *(const f32x4*)(wb + cl + 4);
                    f32x4 g[4][2];
#pragma unroll
                    for (int m = 0; m < 4; ++m) { const f32x4 s0 = sig4(wq0 + acc[ai][bj][m][0]), s1 = sig4(wq1 + acc[ai][bj][m][1]);
#pragma unroll
                        for (int j = 0; j < 4; ++j) { g[m][0][j] = __expf(-0.6065306597126334f * s0[j]); g[m][1][j] = __expf(-0.6065306597126334f * s1[j]); } }
#pragma unroll
                    for (int p = 0; p < 2; ++p)
#pragma unroll
                        for (int h = 0; h < 2; ++h)
#pragma unroll
                            for (int j = 0; j < 4; ++j) { const float a_ = g[2 * p][h][j], b_ = g[2 * p + 1][h][j]; const float ta = allmul16(a_);
                                g[2 * p][h][j] = scanmul16(a_); g[2 * p + 1][h][j] = scanmul16(b_) * ta; }
#pragma unroll
                    for (int m = 0; m < 4; ++m) { const unsigned off = (unsigned)(ai * 128 + wr * 64 + m * 16 + fr) * (unsigned)DM + (unsigned)cl; *(f32x4*)(O + off) = g[m][0]; *(f32x4*)(O + off + 4) = g[m][1]; }
                    asm volatile("" ::: "memory"); }
        } else if (kind == 1) {
            const float* wb = a0 + cb;
            EPI_LOOP_BEGIN(DM) *(u32x4*)(Ob + off) = pack8(sig4(*(const f32x4*)(wb + cl) + v0), sig4(*(const f32x4*)(wb + cl + 4) + v1)); EPI_LOOP_END
        } else {
            EPI_LOOP_BEGIN(DM) *(u32x4*)(Ob + off) = pack8(v0, v1); EPI_LOOP_END
        }
    }
};
struct EpiRes {
    const void* base; int base_f32; const float* gate; void* out; int out_f32;
    __device__ __forceinline__ void operator()(const f32x4 (&acc)[2][2][4][2], const Unit& u, int wr, int wc, int fr, int fq) const {
        const int b = u.pm >> 3; const float* g = gate + (size_t)b * 12288 + u.pn * 256;
        const size_t o0 = (size_t)(u.pm * 256) * DM + u.pn * 256;
        if (base_f32) { const float* B_ = (const float*)base + o0; bf16_t* O = (bf16_t*)out + o0;
            EPI_LOOP_BEGIN(DM) const f32x4 g0 = *(const f32x4*)(g + cl), g1 = *(const f32x4*)(g + cl + 4); const f32x4 b0 = *(const f32x4*)(B_ + off), b1 = *(const f32x4*)(B_ + off + 4);
                *(u32x4*)(O + off) = pack8(b0 + g0 * v0, b1 + g1 * v1); EPI_LOOP_END
        } else if (out_f32) { const bf16_t* B_ = (const bf16_t*)base + o0; float* O = (float*)out + o0;
            EPI_LOOP_BEGIN(DM) const f32x4 g0 = *(const f32x4*)(g + cl), g1 = *(const f32x4*)(g + cl + 4); f32x4 b0, b1; ldbf8(B_ + off, b0, b1);
                *(f32x4*)(O + off) = b0 + g0 * v0; *(f32x4*)(O + off + 4) = b1 + g1 * v1; EPI_LOOP_END
        } else { const bf16_t* B_ = (const bf16_t*)base + o0; bf16_t* O = (bf16_t*)out + o0;
            EPI_LOOP_BEGIN(DM) const f32x4 g0 = *(const f32x4*)(g + cl), g1 = *(const f32x4*)(g + cl + 4); f32x4 b0, b1; ldbf8(B_ + off, b0, b1);
                *(u32x4*)(O + off) = pack8(b0 + g0 * v0, b1 + g1 * v1); EPI_LOOP_END
        }
    }
};
struct EpiUp {
    bf16_t* U;
    __device__ __forceinline__ void operator()(const f32x4 (&acc)[2][2][4][2], const Unit& u, int wr, int wc, int fr, int fq) const {
        bf16_t* O = U + (size_t)(u.pm * 256) * FF + u.pn * 256;
        EPI_LOOP_BEGIN(FF) f32x4 o0, o1;
#pragma unroll
            for (int j = 0; j < 4; ++j) { const float x0 = fmaxf(v0[j], 0.f), x1 = fmaxf(v1[j], 0.f); o0[j] = x0 * x0; o1[j] = x1 * x1; }
            *(u32x4*)(O + off) = pack8(o0, o1); EPI_LOOP_END
    }
};
struct EpiP11 {
    bf16_t* KB;
    __device__ __forceinline__ void operator()(const f32x4 (&acc)[2][2][4][2], const Unit& u, int wr, int wc, int fr, int fq) const {
        const int bb = u.pn >> 3, t0 = (u.pn & 7) * 256;
        bf16_t* O = (u.prob == 1) ? KB + MD + ((size_t)bb * 2048 + u.pm * 256) * 2048 + t0 : KB + (size_t)u.prob * MD + (size_t)(u.pm * 256) * DM + u.pn * 256;
        const float sc = u.prob == 2 ? QSCALE : 1.0f;
        EPI_LOOP_BEGIN(DM) *(u32x4*)(O + off) = pack8(v0 * sc, v1 * sc); EPI_LOOP_END
    }
};

__device__ __forceinline__ unsigned f2bf(float f) { unsigned u = __builtin_bit_cast(unsigned, f); return (u + 0x7fffu + ((u >> 16) & 1u)) >> 16; }
__device__ __forceinline__ unsigned pk2(float lo, float hi) { return f2bf(lo) | (f2bf(hi) << 16); }
__device__ __forceinline__ void transpose_item(const float* W, int K, int N, bf16_t* WT, LAS float* scr, int item, int lane) {
    const int nblk = N / 32, kb = item / nblk, nb = item % nblk, k0 = 64 * kb, n0 = 32 * nb;
#pragma unroll 8
    for (int i = 0; i < 32; ++i) { const int kk = 2 * i + (lane >> 5); scr[kk * 33 + (lane & 31)] = W[(size_t)(k0 + kk) * N + n0 + (lane & 31)]; }
    asm volatile("s_waitcnt lgkmcnt(0)" ::: "memory");
    const int c = lane & 7;
#pragma unroll
    for (int j = 0; j < 4; ++j) { const int n = (lane >> 3) + 8 * j; const LAS float* s = scr + (8 * c) * 33 + n;
        u32x4 o; o.x = pk2(s[0 * 33], s[1 * 33]); o.y = pk2(s[2 * 33], s[3 * 33]); o.z = pk2(s[4 * 33], s[5 * 33]); o.w = pk2(s[6 * 33], s[7 * 33]);
        *(u32x4*)(WT + (size_t)(n0 + n) * K + k0 + 8 * c) = o; }
    asm volatile("s_waitcnt lgkmcnt(0)" ::: "memory");
}
__device__ __forceinline__ void transpose_item64(const float* W, int K, int N, bf16_t* WT, LAS float* scr, int item, int lane) {
    const int nblk = N / 64, kb = item / nblk, nb = item % nblk, k0 = 64 * kb, n0 = 64 * nb;
    const float* src = W + (size_t)k0 * N + n0 + lane;
    float tvv[64];
#pragma unroll
    for (int i = 0; i < 64; ++i) tvv[i] = __builtin_nontemporal_load(src + (size_t)i * N);
#pragma unroll
    for (int i = 0; i < 64; ++i) scr[i * 65 + lane] = tvv[i];
    asm volatile("s_waitcnt lgkmcnt(0)" ::: "memory");
    const int c = lane & 7;
#pragma unroll
    for (int j = 0; j < 8; ++j) { const int n = (lane >> 3) + 8 * j; const LAS float* sp = scr + (8 * c) * 65 + n;
        u32x4 o; o.x = pk2(sp[0 * 65], sp[1 * 65]); o.y = pk2(sp[2 * 65], sp[3 * 65]); o.z = pk2(sp[4 * 65], sp[5 * 65]); o.w = pk2(sp[6 * 65], sp[7 * 65]);
        *(u32x4*)(WT + (size_t)(n0 + n) * K + k0 + 8 * c) = o; }
    asm volatile("s_waitcnt lgkmcnt(0)" ::: "memory");
}
__device__ __forceinline__ void transpose_item32(const float* src, int N, bf16_t* dst, int ldd, LAS float* scr, int lane) {
#pragma unroll
    for (int i = 0; i < 16; ++i) { const int kk = 2 * i + (lane >> 5); scr[kk * 33 + (lane & 31)] = src[(size_t)kk * N + (lane & 31)]; }
    asm volatile("s_waitcnt lgkmcnt(0)" ::: "memory");
    const int c = lane & 3;
#pragma unroll
    for (int j = 0; j < 2; ++j) { const int n = (lane >> 2) + 16 * j; const LAS float* sp = scr + (8 * c) * 33 + n;
        u32x4 o; o.x = pk2(sp[0 * 33], sp[1 * 33]); o.y = pk2(sp[2 * 33], sp[3 * 33]); o.z = pk2(sp[4 * 33], sp[5 * 33]); o.w = pk2(sp[6 * 33], sp[7 * 33]);
        *(u32x4*)(dst + (size_t)n * ldd + 8 * c) = o; }
    asm volatile("s_waitcnt lgkmcnt(0)" ::: "memory");
}
__device__ __forceinline__ void mod_item(const float* W, int N, int ncb, const float* bias, const float* cvec, float* part, int item, int lane) {
    const int kc = item / ncb, cb = item - kc * ncb; const int col = cb * 256 + lane * 4, k0 = kc * 128;
    f32x4 a0 = {0.f, 0.f, 0.f, 0.f}, a1 = a0, a2 = a0, a3 = a0;
    const float* wp = W + (size_t)k0 * N + col;
    for (int k8 = 0; k8 < 128; k8 += 16) {
        f32x4 w[16];
#pragma unroll
        for (int i = 0; i < 16; ++i) w[i] = __builtin_nontemporal_load((const f32x4*)(wp + (size_t)(k8 + i) * N));
#pragma unroll
        for (int i = 0; i < 16; ++i) { const int kk = k0 + k8 + i; a0 += w[i] * cvec[kk]; a1 += w[i] * cvec[DM + kk]; a2 += w[i] * cvec[2 * DM + kk]; a3 += w[i] * cvec[3 * DM + kk]; }
    }
    if (kc == 0) { const f32x4 bv = *(const f32x4*)(bias + col); a0 += bv; a1 += bv; a2 += bv; a3 += bv; }
    float* o = part + (size_t)(kc * 4) * 4096 + col;
    *(f32x4*)(o) = a0; *(f32x4*)(o + 4096) = a1; *(f32x4*)(o + 2 * 4096) = a2; *(f32x4*)(o + 3 * 4096) = a3;
}

struct Args { const float* in[35]; float* out; unsigned char* ws; };
#define TR_LOAD(tv, W, N, item) do { const int nblk_ = (N) / 32, kb_ = (item) / nblk_, nb_ = (item) % nblk_; const float* src_ = (W) + (size_t)(64 * kb_ + (lane >> 5)) * (N) + 32 * nb_ + (lane & 31); \
        _Pragma("unroll") for (int i_ = 0; i_ < 32; ++i_) tv(i_) = __builtin_nontemporal_load(src_ + (size_t)(2 * i_) * (N)); } while (0)
#define TR_STORE(tv, K, N, WT, scr, item) do { const int nblk_ = (N) / 32, kb_ = (item) / nblk_, nb_ = (item) % nblk_, k0_ = 64 * kb_, n0_ = 32 * nb_; \
        _Pragma("unroll") for (int i_ = 0; i_ < 32; ++i_) (scr)[(2 * i_ + (lane >> 5)) * 33 + (lane & 31)] = tv(i_); \
        asm volatile("s_waitcnt lgkmcnt(0)" ::: "memory"); const int c_ = lane & 7; \
        _Pragma("unroll") for (int j_ = 0; j_ < 4; ++j_) { const int n_ = (lane >> 3) + 8 * j_; const LAS float* sp_ = (scr) + (8 * c_) * 33 + n_; \
            u32x4 o_; o_.x = pk2(sp_[0 * 33], sp_[1 * 33]); o_.y = pk2(sp_[2 * 33], sp_[3 * 33]); o_.z = pk2(sp_[4 * 33], sp_[5 * 33]); o_.w = pk2(sp_[6 * 33], sp_[7 * 33]); \
            *(u32x4*)((WT) + (size_t)(n0_ + n_) * (K) + k0_ + 8 * c_) = o_; } \
        asm volatile("s_waitcnt lgkmcnt(0)" ::: "memory"); } while (0)
constexpr int LATER_ITEMS = 4 * 8192 + 4 * 2048;
__device__ __forceinline__ void later_src(const Args& a, unsigned char* ws, int slot, const float*& W, int& K, int& N, bf16_t*& WT, int& item) {
    int r = slot;
    if (r < 16384) { const int l = r >> 13; W = a.in[6] + (size_t)l * DM * FF; K = DM; N = FF; WT = (bf16_t*)(ws + WB_UP + (size_t)l * 32 * MiB); item = r & 8191; return; } r -= 16384;
    if (r < 16384) { const int l = r >> 13; W = a.in[7] + (size_t)l * DM * FF; K = FF; N = DM; WT = (bf16_t*)(ws + WB_DN + (size_t)l * 32 * MiB); item = r & 8191; return; } r -= 16384;
    K = DM; N = DM; item = r & 2047; const int q = r >> 11;
    W = q == 0 ? a.in[32] : (q == 1 ? a.in[33] : (q == 2 ? a.in[26] : a.in[27]));
    WT = (bf16_t*)(ws + (q == 3 ? WB_AO : WB_KVQ + (size_t)q * 8 * MiB));
}


__device__ __forceinline__ void phase0(const Args& a, LAS unsigned char* lds, const bool do_mod) {
    const int tid = launder_tid(), lane = tid & 63, wave = tid >> 6;
    const int gw = blockIdx.x * 8 + wave, NGW = gridDim.x * 8;
    unsigned char* ws = launder(a.ws);
    LAS float* scr = (LAS float*)(lds + wave * 16640);
    constexpr int I_SQ = 1024, I_96 = 96, I_256 = 128;
    constexpr int NITEMS = 4 * I_SQ + 2 * I_96 + I_256;
    for (int it = gw; it < NITEMS; it += NGW) {
        int r = it;
        if (r < 3 * I_SQ) { const int s = r / I_SQ; transpose_item64(s == 0 ? a.in[9] : (s == 1 ? a.in[10] : a.in[11]), DM, DM, (bf16_t*)(ws + WB_RKV + (size_t)s * 8 * MiB), scr, r % I_SQ, lane); continue; } r -= 3 * I_SQ;
        if (r < I_96) { transpose_item(a.in[14], DM, 96, (bf16_t*)(ws + WB_RKV + 3 * 8 * MiB), scr, r, lane); continue; } r -= I_96;
        if (r < I_96) { transpose_item(a.in[17], DM, 96, (bf16_t*)(ws + WB_RKV + 4 * 8 * MiB), scr, r, lane); continue; } r -= I_96;
        if (r < I_256) { transpose_item64(a.in[19], DM, 256, (bf16_t*)(ws + WB_RKV + 5 * 8 * MiB), scr, r, lane); continue; } r -= I_256;
        transpose_item64(a.in[12], DM, DM, (bf16_t*)(ws + WB_O), scr, r, lane);
    }
    { const int gt = blockIdx.x * 512 + tid, NGT = gridDim.x * 512; constexpr int PER = 160 * DM * 2 / 16;
      for (int i = gt; i < 2 * PER; i += NGT) { const int s = i / PER, o = i % PER; *(u32x4*)(ws + WB_RKV + (size_t)(3 + s) * 8 * MiB + (size_t)96 * DM * 2 + (size_t)o * 16) = (u32x4){0u, 0u, 0u, 0u}; }
      for (int i = gt; i < 6144 * 64; i += NGT) { const int n = i >> 6, p = i & 63, blk = n >> 11;
          const bool dense = blk == 0 ? (p < 12) : (blk == 1 ? (p >= 12 && p < 24) : (p >= 24 && p < 56));
          if (!dense) *(u32x4*)(ws + WB_L2 + (size_t)n * 1024 + (size_t)p * 16) = (u32x4){0u, 0u, 0u, 0u}; } }
    { const float* w2 = a.in[15]; const float* a2 = a.in[18]; const float* g2 = a.in[20]; bf16_t* B2 = (bf16_t*)(ws + WB_L2);
      for (int it = gw; it < 14 * 64; it += NGW) { const int kbi = it >> 6, nb = it & 63;
          const float* src; int nrow0, kcol0;
          if (kbi < 3) { src = w2 + (size_t)(32 * kbi) * DM; nrow0 = 0; kcol0 = 32 * kbi; }
          else if (kbi < 6) { src = a2 + (size_t)(32 * (kbi - 3)) * DM; nrow0 = 2048; kcol0 = 96 + 32 * (kbi - 3); }
          else { src = g2 + (size_t)(32 * (kbi - 6)) * DM; nrow0 = 4096; kcol0 = 192 + 32 * (kbi - 6); }
          transpose_item32(src + 32 * nb, DM, B2 + (size_t)(nrow0 + 32 * nb) * 512 + kcol0, 512, scr, lane); } }
    if (do_mod) { float* mod = (float*)(ws + WS_CTL); const float* cvec = a.in[1];
      for (int it = gw; it < 16 * 16; it += NGW) mod_item(a.in[2], 12288, 16, a.in[3], cvec, (float*)(ws + WS_PART0), it, lane);
    }
}

__device__ __forceinline__ void phase_mix(const Args& a, LAS unsigned char* lds) {
    unsigned char* ws = launder(a.ws);
    const int tid = launder_tid(), lane = tid & 63, wave = tid >> 6;
    const int gw = blockIdx.x * 8 + wave, NGW = gridDim.x * 8;
    const float* x = a.in[0]; const float* gmix = a.in[4]; const float* mu = a.in[8];
    const float* mod0 = (const float*)(ws + WS_CTL);
    bf16_t* AX = (bf16_t*)(ws + WS_AX6); bf16_t* A2 = (bf16_t*)(ws + WS_A2);
    LAS float* M0 = (LAS float*)lds;
    { const float* P0 = (const float*)(ws + WS_PART0);
      for (int i = tid; i < 4096; i += 512) { f32x4 v = *(const f32x4*)(P0 + i * 4);
#pragma unroll 5
          for (int kc = 1; kc < 16; ++kc) v += *(const f32x4*)(P0 + (size_t)kc * 16384 + i * 4);
          *(LAS f32x4*)(M0 + i * 4) = v; }
      LAS float* MU_ = M0 + 16384; for (int i = tid; i < 6 * 512; i += 512) *(LAS f32x4*)(MU_ + i * 4) = *(const f32x4*)(mu + i * 4);
      LAS float* GM_ = M0 + 16384 + 6 * 2048; for (int i = tid; i < 512; i += 512) *(LAS f32x4*)(GM_ + i * 4) = *(const f32x4*)(gmix + i * 4);
      __syncthreads(); }
    const LAS float* MU = M0 + 16384; const LAS float* GM = M0 + 16384 + 6 * 2048;
    for (int item = gw; item < MTOK / 4; item += NGW) {
        const int row0 = item * 4, b = row0 / TT, t0 = row0 % TT;
        const LAS float* scp = M0 + b * 4096 + 2048 + lane * 4; const LAS float* shp = M0 + b * 4096 + lane * 4;
        f32x4 hp[8];
#pragma unroll
        for (int j = 0; j < 8; ++j) hp[j] = (f32x4){0.f, 0.f, 0.f, 0.f};
        for (int rr = (t0 == 0 ? 0 : -1); rr < 4; ++rr) {
            const int row = row0 + rr;
            f32x4 h[8]; float ss = 0.f;
#pragma unroll
            for (int j = 0; j < 8; ++j) { h[j] = *(const f32x4*)(x + (size_t)row * DM + j * 256 + lane * 4); ss += dot4(h[j], h[j]); }
            ss = allreduce64(ss); const float rstd = rsqrtf(ss * (1.0f / DM) + RMS_EPS);
#pragma unroll
            for (int j = 0; j < 8; ++j) { const f32x4 g = *(const LAS f32x4*)(GM + j * 256 + lane * 4), sc = *(const LAS f32x4*)(scp + j * 256), sh = *(const LAS f32x4*)(shp + j * 256); h[j] = (h[j] * rstd * g) * (1.0f + sc) + sh; }
            asm volatile("" ::: "memory");
            if (rr >= 0) {
#pragma unroll
                for (int q = 0; q < 6; ++q) { const int slot = (q == 0) ? 0 : (q == 1) ? 3 : (q == 2) ? 1 : (q == 3) ? 2 : q;
                    bf16_t* O = AX + (size_t)slot * MD + (size_t)row * DM + lane * 4;
#pragma unroll
                    for (int j = 0; j < 8; ++j) { const f32x4 m = *(const LAS f32x4*)(MU + q * DM + j * 256 + lane * 4); const f32x4 xv = h[j] + (hp[j] - h[j]) * m; *(u32x2*)(O + j * 256) = pack4(xv); }
                    asm volatile("" ::: "memory"); }
                if (lane < 16) *(u32x2*)(A2 + (size_t)row * 512 + 448 + lane * 4) = (u32x2){0u, 0u};
            }
#pragma unroll
            for (int j = 0; j < 8; ++j) hp[j] = h[j];
        }
    }
}

__device__ __forceinline__ float allreduce8(float v) { v += dppmov<0xB1>(v); v += dppmov<0x4E>(v); v += dppmov<0x141>(v); return v; }
__device__ __forceinline__ void phase_scan(const Args& a, LAS unsigned char* lds) {
    unsigned char* ws = launder(a.ws);
    const int tid = launder_tid();
    LAS float* L = (LAS float*)lds;
    constexpr int BUF = 5 * 2048 + 1024 + 64;
    const bf16_t* Rg = (const bf16_t*)(ws + WS_RKV); const bf16_t* Kg = Rg + MD; const bf16_t* Vg = Rg + 2 * MD;
    const float* DECg = (const float*)(ws + WS_DEC); const bf16_t* AAg = (const bf16_t*)(DECg + MD);
    float* Yg = (float*)(ws + WS_Y); float* BON = (float*)(ws + WS_BON);
#define SCAN_BAR() do { asm volatile("s_waitcnt lgkmcnt(0)" ::: "memory"); __builtin_amdgcn_s_barrier(); asm volatile("" ::: "memory"); } while (0)
    for (int item = blockIdx.x; item < 256; item += gridDim.x) {
        const int xcd = item & 7, jj = item >> 3, half = jj & 1, bh = xcd * 16 + (jj >> 1), b = bh >> 5, h = bh & 31;
        if (tid < 256) {
            const int row = tid >> 3, seg = (tid & 7) * 8, l8 = tid & 7;
            f32x2 s01 = {0.f, 0.f}, s23 = s01, s45 = s01, s67 = s01; float sa = 0.f;
#ifdef EXPA
            f32x2 d01 = {0.f, 0.f}, d23 = d01, d45 = d01, d67 = d01; float sad = 0.f, dsum = 0.f;
#endif
            SCAN_BAR();
            for (int c = 0; c < 64; ++c) {
                const LAS float* Bf = L + (c & 1) * BUF + seg; LAS float* Yb = L + 2 * BUF + (c & 1) * 1024; const LAS float* Vb = L + (c & 1) * BUF + 10240 + row; const LAS float* Sc = L + (c & 1) * BUF + 11264;
#define LD8(lo, hi, off) lo = *(const LAS f32x4*)(Bf + (off)); hi = *(const LAS f32x4*)(Bf + (off) + 4)
#define LO2(v) __builtin_shufflevector(v, v, 0, 1)
#define HI2(v) __builtin_shufflevector(v, v, 2, 3)
                f32x4 na, nb, ka, kb, ba, bb, ra, rb; float vv; f32x2 bk;
                { LD8(na, nb, 6144); LD8(ka, kb, 4096); LD8(ba, bb, 8192); LD8(ra, rb, 0); vv = Vb[0]; bk = *(const LAS f32x2*)(Sc); }
                for (int t = 0; t < 32; t += 4) {
                    float yp[4];
#pragma unroll
                    for (int j = 0; j < 4; ++j) {
                        const int to = (t + j + 1) * 64;
                        f32x4 na_, nb_, ka_, kb_, ba_, bb_, ra_, rb_;
                        LD8(na_, nb_, 6144 + to); LD8(ka_, kb_, 4096 + to); LD8(ba_, bb_, 8192 + to); LD8(ra_, rb_, to); const float vv_ = Vb[(t + j + 1) * 32];
                        const f32x2 bk_ = *(const LAS f32x2*)(Sc + (t + j + 1) * 2);
                        __builtin_amdgcn_sched_barrier(0);
                        f32x2 p = s01 * LO2(na), p2 = s23 * HI2(na); p = s45 * LO2(nb) + p; p2 = s67 * HI2(nb) + p2; p = p + p2;
                        const f32x2 vv2 = {vv, vv}, sa2 = {sa, sa};
                        const float base = sa * bk.x + vv * bk.y;
                        const float P = allreduce8(p.x + p.y);
                        s01 = vv2 * LO2(ka) + s01; s23 = vv2 * HI2(ka) + s23; s45 = vv2 * LO2(kb) + s45; s67 = vv2 * HI2(kb) + s67;
                        s01 = sa2 * LO2(ba) + s01; s23 = sa2 * HI2(ba) + s23; s45 = sa2 * LO2(bb) + s45; s67 = sa2 * HI2(bb) + s67;
                        sa = P + base;
                        f32x2 q = s01 * LO2(ra), q2 = s23 * HI2(ra); q = s45 * LO2(rb) + q; q2 = s67 * HI2(rb) + q2; q = q + q2;
                        yp[j] = q.x + q.y;
#ifdef EXPA
                        { f32x2 pd = d01 * LO2(na), pd2 = d23 * HI2(na); pd = d45 * LO2(nb) + pd; pd2 = d67 * HI2(nb) + pd2; pd = pd + pd2;
                          f32x2 u01 = vv2 * LO2(kb), u23 = vv2 * HI2(kb), u45 = vv2 * LO2(ka), u67 = vv2 * HI2(ka);
                          const float Pd = allreduce8(pd.x + pd.y); const f32x2 sd2 = {sad, sad};
                          u01 = sd2 * LO2(ba) + u01; u23 = sd2 * HI2(ba) + u23; u45 = sd2 * LO2(bb) + u45; u67 = sd2 * HI2(bb) + u67;
                          d01 = d01 * LO2(wa) + u01; d23 = d23 * HI2(wa) + u23; d45 = d45 * LO2(wb) + u45; d67 = d67 * HI2(wb) + u67;
                          sad = Pd + sad * bk.x;
                          f32x2 qd = d01 * LO2(ra), qd2 = d23 * HI2(ra); qd = d45 * LO2(rb) + qd; qd2 = d67 * HI2(rb) + qd2; qd = qd + qd2; dsum += allreduce8(qd.x + qd.y); }
#endif
#ifdef EXPB
                        { f32x4 x0, x1, x2, x3, x4, x5, x6, x7, x8, x9; const int tb = (t + j) * 64;
                          LD8(x0, x1, 6144 + tb); LD8(x2, x3, 4096 + tb); LD8(x4, x5, 8192 + tb); LD8(x6, x7, 2048 + tb); LD8(x8, x9, tb);
                          asm volatile("" :: "v"(x0), "v"(x1), "v"(x2), "v"(x3), "v"(x4), "v"(x5), "v"(x6), "v"(x7), "v"(x8), "v"(x9)); }
#endif
                        na = na_; nb = nb_; ka = ka_; kb = kb_; ba = ba_; bb = bb_; ra = ra_; rb = rb_; vv = vv_; bk = bk_;
                    }
#pragma unroll
                    for (int j = 0; j < 4; ++j) yp[j] = allreduce8(yp[j]);
                    const float yv = l8 == 0 ? yp[0] : (l8 == 1 ? yp[1] : (l8 == 2 ? yp[2] : yp[3]));
                    if (l8 < 4) Yb[(t + l8) * 32 + row] = yv;
                }
                { const f32x4 g0 = *(const LAS f32x4*)(Bf + 2048), g1 = *(const LAS f32x4*)(Bf + 2048 + 4);
                  s01 *= LO2(g0); s23 *= HI2(g0); s45 *= LO2(g1); s67 *= HI2(g1); }
#undef LO2
#undef HI2
#undef LD8
                SCAN_BAR();
            }
#ifdef EXPA
            asm volatile("" :: "v"(dsum));
#endif
        } else {
            const int lt = tid - 256, tl = lt >> 4, c4 = (lt & 15) * 4;
            const f32x4 kk4 = *(const f32x4*)(a.in[21] + h * 64 + c4), ka4 = *(const f32x4*)(a.in[22] + h * 64 + c4), rk4 = *(const f32x4*)(a.in[23] + h * 64 + c4);
            const size_t gbase = (size_t)(b * TT) * DM + h * 64 + c4;
            u32x2 prA0, pkA0, pvA0, paA0, pnA0, prA1, pkA1, pvA1, paA1, pnA1; f32x4 lwA0, lwA1;
#define SCAN_LOAD1(c, X, u) do { const size_t o_ = gbase + (size_t)((c) * 32 + tl + 16 * (u)) * DM; pr##X##u = *(const u32x2*)(Rg + o_); pk##X##u = *(const u32x2*)(Kg + o_); pv##X##u = *(const u32x2*)(Vg + o_); lw##X##u = *(const f32x4*)(DECg + o_); pa##X##u = *(const u32x2*)(AAg + o_); \
                pn##X##u = ((c) * 32 + tl + 16 * (u) + 1 < TT) ? *(const u32x2*)(Kg + o_ + DM) : (u32x2){0u, 0u}; } while (0)
#define SCAN_LOAD(c, X) do { SCAN_LOAD1(c, X, 0); SCAN_LOAD1(c, X, 1); } while (0)
#define SCAN_PREP1(c, X, u) do { LAS float* Bf_ = L + ((c) & 1) * BUF; const int tq = tl + 16 * (u); \
                const f32x4 lr##X##u = cvt4(pr##X##u), lk##X##u = cvt4(pk##X##u), lv##X##u = cvt4(pv##X##u), la##X##u = cvt4(pa##X##u), ln##X##u = cvt4(pn##X##u); \
                const f32x4 kkv = lk##X##u * kk4; float ss = allreduce16(dot4(kkv, kkv)); const float inv = fminf(__builtin_amdgcn_rsqf(ss), 1e12f); const f32x4 kkn = kkv * inv;     \
                const f32x4 kkv1 = ln##X##u * kk4; float ss1 = allreduce16(dot4(kkv1, kkv1)); const float inv1 = fminf(__builtin_amdgcn_rsqf(ss1), 1e12f); const f32x4 nn1 = -(kkv1 * inv1); \
                const f32x4 km = lk##X##u * (1.0f + (la##X##u - 1.0f) * ka4); const f32x4 bb = kkn * la##X##u; \
                float bon = allreduce16(dot4(lr##X##u * km, rk4)); if (half == 0 && (lt & 15) == 0) BON[(size_t)(b * TT + (c) * 32 + tq) * 32 + h] = bon; \
                const float beta = allreduce16(dot4(bb, nn1)), kappa = allreduce16(dot4(km, nn1)); \
                const f32x4 G_ = lw##X##u; f32x4 iG_; iG_[0] = __builtin_amdgcn_rcpf(G_[0]); iG_[1] = __builtin_amdgcn_rcpf(G_[1]); iG_[2] = __builtin_amdgcn_rcpf(G_[2]); iG_[3] = __builtin_amdgcn_rcpf(G_[3]);     \
                *(LAS f32x4*)(Bf_ + tq * 64 + c4) = lr##X##u * G_; *(LAS f32x4*)(Bf_ + 4096 + tq * 64 + c4) = km * iG_; \
                *(LAS f32x4*)(Bf_ + 6144 + tq * 64 + c4) = G_ * nn1; *(LAS f32x4*)(Bf_ + 8192 + tq * 64 + c4) = bb * iG_; \
                if (tq == 31) *(LAS f32x4*)(Bf_ + 2048 + c4) = G_;     \
                if ((lt & 15) == 0) *(LAS f32x2*)(Bf_ + 11264 + tq * 2) = (f32x2){beta, kappa}; \
                if ((c4 >> 5) == half) *(LAS f32x4*)(Bf_ + 10240 + tq * 32 + (c4 & 31)) = lv##X##u; } while (0)
#define SCAN_PREP(c, X) do { SCAN_PREP1(c, X, 0); SCAN_PREP1(c, X, 1); } while (0)
#define SCAN_YOUT(c) do { const LAS float* Yb = L + 2 * BUF + ((c) & 1) * 1024; const int idx = lt * 4, t = idx >> 5, rw = idx & 31; const f32x4 v = *(const LAS f32x4*)(Yb + idx); \
                *(f32x4*)(Yg + (size_t)(b * TT + (c) * 32 + t) * DM + h * 64 + half * 32 + rw) = v; } while (0)
            const int lane = lt & 63, lw = __builtin_amdgcn_readfirstlane(lt >> 6); LAS float* scr = L + 2 * BUF + 2048 + lw * (64 * 33);
            f32x4 tq[8]; const float* tW; int tK, tN, tItem; bf16_t* tWT;
#define tv(i) tq[(i) >> 2][(i) & 3]
            const int mtask = item * 2 + lw; const bool domod = (lw < 2) && (item < 192);
            const int mkq = mtask & 3;
#define MOD_DECODE() const int cbg_ = mtask >> 2; const float* mW = cbg_ < 32 ? a.in[2] : (cbg_ < 80 ? a.in[2] + (size_t)DM * 12288 : a.in[29]); const int mN = cbg_ < 80 ? 12288 : 4096; \
            const int mcol = cbg_ < 32 ? (16 + cbg_) * 256 : (cbg_ < 80 ? (cbg_ - 32) * 256 : (cbg_ - 80) * 256);
#define LATER_BEGIN(c) const int widx_ = item < 192 ? item * 2 + (lw - 2) : 384 + (item - 192) * 4 + lw; const int slot_ = (c) * 640 + widx_; const bool do_ = !domod && slot_ < LATER_ITEMS; if (do_) { later_src(a, ws, slot_, tW, tK, tN, tWT, tItem); TR_LOAD(tv, tW, tN, tItem); }
#define LATER_END(c) if (do_) { TR_STORE(tv, tK, tN, tWT, scr, tItem); }
            const float* cvec = a.in[1];
            f32x4 m0 = {0.f, 0.f, 0.f, 0.f}, m1 = m0, m2 = m0, m3 = m0;
#define MOD_LOAD(c) if (domod) { MOD_DECODE() const float* p_ = mW + (size_t)(mkq * 512 + (c) * 8) * mN + mcol + lane * 4; _Pragma("unroll") for (int i_ = 0; i_ < 8; ++i_) tq[i_] = __builtin_nontemporal_load((const f32x4*)(p_ + (size_t)i_ * mN)); }
#define MOD_FMA(c) if (domod) { const int r_ = mkq * 512 + (c) * 8; _Pragma("unroll") for (int i_ = 0; i_ < 8; ++i_) { m0 += tq[i_] * cvec[r_ + i_]; m1 += tq[i_] * cvec[DM + r_ + i_]; m2 += tq[i_] * cvec[2 * DM + r_ + i_]; m3 += tq[i_] * cvec[3 * DM + r_ + i_]; } }
            SCAN_LOAD(0, A); SCAN_PREP(0, A); SCAN_LOAD(1, A); MOD_LOAD(0)
            SCAN_BAR();
            for (int c = 0; c < 64; ++c) {
                MOD_FMA(c)
                if (c + 1 < 64) SCAN_PREP(c + 1, A);
                LATER_BEGIN(c)
                if (c + 2 < 64) SCAN_LOAD(c + 2, A);
                if (c >= 1) SCAN_YOUT(c - 1);
                LATER_END(c)
                if (c + 1 < 64) { MOD_LOAD(c + 1) }
                SCAN_BAR();
            }
            if (domod) {
                MOD_DECODE() (void)mW; (void)mN; const float* mBias = cbg_ < 32 ? a.in[3] : (cbg_ < 80 ? a.in[3] + 12288 : a.in[30]);
                if (mkq == 0) { const f32x4 bv = *(const f32x4*)(mBias + mcol + lane * 4); m0 += bv; m1 += bv; m2 += bv; m3 += bv; }
                float* o_ = (float*)(ws + WS_PARTS) + (size_t)mtask * 1024 + lane * 4;
                *(f32x4*)(o_) = m0; *(f32x4*)(o_ + 256) = m1; *(f32x4*)(o_ + 512) = m2; *(f32x4*)(o_ + 768) = m3;
            }
#undef MOD_LOAD
#undef MOD_FMA
#undef MOD_DECODE
#undef tv
#undef LATER_BEGIN
#undef LATER_END
            SCAN_YOUT(63);
#undef SCAN_LOAD1
#undef SCAN_LOAD
#undef SCAN_PREP1
#undef SCAN_PREP
#undef SCAN_YOUT
        }
        __syncthreads();
    }
#undef SCAN_BAR
}

__device__ __forceinline__ void phase_gn(const Args& a, LAS unsigned char* lds) {
    unsigned char* ws = launder(a.ws);
    const int tid = launder_tid(), lane = tid & 63, wave = tid >> 6;
    const int gw = blockIdx.x * 8 + wave, NGW = gridDim.x * 8;
    const float* Yg = (const float*)(ws + WS_Y); const float* BON = (const float*)(ws + WS_BON);
    const bf16_t* Vg = (const bf16_t*)(ws + WS_RKV) + 2 * MD; const bf16_t* GG = (const bf16_t*)((const float*)(ws + WS_DEC) + MD) + MD;
    const float* lnw = a.in[24]; const float* lnb = a.in[25]; bf16_t* YG = (bf16_t*)(ws + WS_YG);
    { const float* PS = (const float*)(ws + WS_PARTS); float* mod = (float*)(ws + WS_CTL);
      for (int i = blockIdx.x * 512 + tid; i < 96 * 4 * 64; i += gridDim.x * 512) { const int l4 = i & 63, bq = (i >> 6) & 3, cbg = i >> 8;
          const float* p = PS + (size_t)(cbg * 4) * 1024 + bq * 256 + l4 * 4;
          const f32x4 v = ((*(const f32x4*)p + *(const f32x4*)(p + 1024)) + *(const f32x4*)(p + 2048)) + *(const f32x4*)(p + 3072);
          float* o = cbg < 32 ? mod + (size_t)bq * 12288 + (16 + cbg) * 256 : (cbg < 80 ? mod + 4 * 12288 + (size_t)bq * 12288 + (cbg - 32) * 256 : mod + 2 * 4 * 12288 + (size_t)bq * 4096 + (cbg - 80) * 256);
          *(f32x4*)(o + l4 * 4) = v; } }
    LAS float* LW = (LAS float*)lds; LAS float* LB = LW + 2048;
    for (int i = tid; i < 512; i += 512) { *(LAS f32x4*)(LW + i * 4) = *(const f32x4*)(lnw + i * 4); *(LAS f32x4*)(LB + i * 4) = *(const f32x4*)(lnb + i * 4); }
    __syncthreads();
    f32x4 yq[8]; u32x2 vq[8], gq[8]; float bq[8];
#define GN_LOAD(r_) _Pragma("unroll") for (int j = 0; j < 8; ++j) { const size_t o_ = (size_t)(r_) * DM + j * 256 + lane * 4; yq[j] = *(const f32x4*)(Yg + o_); vq[j] = *(const u32x2*)(Vg + o_); gq[j] = *(const u32x2*)(GG + o_); bq[j] = BON[(size_t)(r_) * 32 + j * 4 + (lane >> 4)]; }
    if (gw < MTOK) { GN_LOAD(gw) }
    for (int row = gw; row < MTOK; row += NGW) {
        f32x4 y[8], v[8], g[8]; float bn[8];
#pragma unroll
        for (int j = 0; j < 8; ++j) { y[j] = yq[j]; v[j] = cvt4(vq[j]); g[j] = cvt4(gq[j]); bn[j] = bq[j]; }
        if (row + NGW < MTOK) { GN_LOAD(row + NGW) }
#pragma unroll
        for (int j = 0; j < 8; ++j) { const int col = j * 256 + lane * 4; const size_t o = (size_t)row * DM + col;
            const float mean = allreduce16(sum4(y[j])) * (1.0f / 64.0f); const f32x4 d = y[j] - mean;
            const float var = allreduce16(dot4(d, d)) * (1.0f / 64.0f); const float rs = rsqrtf(var + GN_EPS);
            f32x4 yn = d * rs * *(const LAS f32x4*)(LW + col) + *(const LAS f32x4*)(LB + col);
            yn += v[j] * bn[j];
            *(u32x2*)(YG + o) = pack4(yn * g[j]); }
    }
#undef GN_LOAD
}

__device__ __forceinline__ void phase_norm(LAS unsigned char* lds, const void* X, const bool xf32, const float* gA, const float* scA, const float* shA, int strideA, bf16_t* outA,
                                           const float* gB, const float* scB, const float* shB, int strideB, bf16_t* outB, const float* gF, float* outF) {
    const int tid = launder_tid(), lane = tid & 63, wave = tid >> 6;
    const int gw = blockIdx.x * 8 + wave, NGW = gridDim.x * 8;
    LAS float* GA = (LAS float*)lds; LAS float* SA = GA + 8192; LAS float* GB = GA + 16384; LAS float* SB = GA + 24576; LAS float* GF = GA;
    if (outA) for (int i = tid; i < 2048; i += 512) { const int b = i >> 9, c = (i & 511) * 4; const f32x4 g = *(const f32x4*)(gA + c), sc = *(const f32x4*)(scA + (size_t)b * strideA + c);
        *(LAS f32x4*)(GA + b * 2048 + c) = g * (1.0f + sc); *(LAS f32x4*)(SA + b * 2048 + c) = *(const f32x4*)(shA + (size_t)b * strideA + c); }
    if (outB) for (int i = tid; i < 2048; i += 512) { const int b = i >> 9, c = (i & 511) * 4; const f32x4 g = *(const f32x4*)(gB + c), sc = *(const f32x4*)(scB + (size_t)b * strideB + c);
        *(LAS f32x4*)(GB + b * 2048 + c) = g * (1.0f + sc); *(LAS f32x4*)(SB + b * 2048 + c) = *(const f32x4*)(shB + (size_t)b * strideB + c); }
    if (outF) for (int i = tid; i < 512; i += 512) *(LAS f32x4*)(GF + i * 4) = *(const f32x4*)(gF + i * 4);
    __syncthreads();
    u32x2 xr[8]; f32x4 xq[8];
    if (gw < MTOK) {
#pragma unroll
        for (int j = 0; j < 8; ++j) { const size_t o_ = (size_t)gw * DM + j * 256 + lane * 4; if (xf32) xq[j] = *(const f32x4*)((const float*)X + o_); else xr[j] = *(const u32x2*)((const bf16_t*)X + o_); }
    }
    for (int row = gw; row < MTOK; row += NGW) {
        const int b = row / TT;
        f32x4 xv[8]; float ss = 0.f;
#pragma unroll
        for (int j = 0; j < 8; ++j) { xv[j] = xf32 ? xq[j] : cvt4(xr[j]); ss += dot4(xv[j], xv[j]); }
        if (row + NGW < MTOK) {
#pragma unroll
            for (int j = 0; j < 8; ++j) { const size_t o_ = (size_t)(row + NGW) * DM + j * 256 + lane * 4; if (xf32) xq[j] = *(const f32x4*)((const float*)X + o_); else xr[j] = *(const u32x2*)((const bf16_t*)X + o_); }
        }
        ss = allreduce64(ss); const float rstd = rsqrtf(ss * (1.0f / DM) + RMS_EPS);
        if (outA) {
#pragma unroll
            for (int j = 0; j < 8; ++j) { const int col = j * 256 + lane * 4;
                *(u32x2*)(outA + (size_t)row * DM + col) = pack4((xv[j] * rstd) * *(const LAS f32x4*)(GA + b * 2048 + col) + *(const LAS f32x4*)(SA + b * 2048 + col)); } }
        if (outB) {
#pragma unroll
            for (int j = 0; j < 8; ++j) { const int col = j * 256 + lane * 4;
                *(u32x2*)(outB + (size_t)row * DM + col) = pack4((xv[j] * rstd) * *(const LAS f32x4*)(GB + b * 2048 + col) + *(const LAS f32x4*)(SB + b * 2048 + col)); } }
        if (outF) {
#pragma unroll
            for (int j = 0; j < 8; ++j) { const int col = j * 256 + lane * 4; *(f32x4*)(outF + (size_t)row * DM + col) = xv[j] * rstd * *(const LAS f32x4*)(GF + col); } }
    }
    __syncthreads();
}

__device__ __forceinline__ void phase_attn(const Args& a, LAS unsigned char* lds) {
    unsigned char* ws = launder(a.ws);
    const int tid = launder_tid(), lane = tid & 63, wave = tid >> 6, r32 = lane & 31, hi = lane >> 5;
    LAS float* tab = (LAS float*)(lds + wave * 2304);
    const int gw = blockIdx.x * 8 + wave, NGW = gridDim.x * 8;
    const bf16_t* Kb = (const bf16_t*)(ws + WS_KB); const bf16_t* Vt = Kb + MD; const bf16_t* Qb = Kb + 2 * MD; bf16_t* Ob = (bf16_t*)(ws + WS_KB) + 3 * MD;
    const float* relb_g = a.in[28];
    const int pi = (r32 & ~12) | ((r32 & 4) << 1) | ((r32 & 8) >> 1);
    int cur_h = -1;
    for (int u = gw; u < 4096; u += NGW) {
        const int bh = u >> 5, n = u & 31, b = bh >> 5, h = bh & 31;
        if (h != cur_h) { for (int i = lane; i < 513; i += 64) tab[i] = relb_g[h * 513 + i] * LOG2E; cur_h = h; }
        const bf16_t* qbase = Qb + (size_t)(b * TT + n * 64) * DM + h * 64;
        bf16x8 qf[2][4];
#pragma unroll
        for (int qt = 0; qt < 2; ++qt)
#pragma unroll
            for (int kk = 0; kk < 4; ++kk) qf[qt][kk] = *(const bf16x8*)(qbase + (size_t)(qt * 32 + r32) * DM + kk * 16 + hi * 8);
        f32x16 ot[2][2];
#pragma unroll
        for (int i = 0; i < 2; ++i)
#pragma unroll
            for (int j = 0; j < 2; ++j)
#pragma unroll
                for (int r = 0; r < 16; ++r) ot[i][j][r] = 0.f;
        float mrow[2] = {-1e30f, -1e30f}, lrow[2] = {0.f, 0.f};
        const int jc0 = n < 8 ? 8 - n : 0;
        bf16x8 kf[4];
        { const bf16_t* kp = Kb + (size_t)(b * TT + n * 64 - 512 + jc0 * 64 + pi) * DM + h * 64 + hi * 8;
#pragma unroll
          for (int kk = 0; kk < 4; ++kk) kf[kk] = *(const bf16x8*)(kp + kk * 16); }
        for (int tile = jc0 * 2; tile < 18; ++tile) {
            const int kt0 = n * 64 - 512 + tile * 32;
            const bf16_t* vp = Vt + (size_t)(b * 2048 + h * 64 + r32) * 2048 + kt0 + hi * 8;
            bf16x8 vf[2][2];
#pragma unroll
            for (int dt = 0; dt < 2; ++dt)
#pragma unroll
                for (int mm = 0; mm < 2; ++mm) vf[dt][mm] = *(const bf16x8*)(vp + (size_t)dt * 32 * 2048 + mm * 16);
            f32x16 st[2];
#pragma unroll
            for (int qt = 0; qt < 2; ++qt) {
#pragma unroll
                for (int r = 0; r < 16; ++r) st[qt][r] = 0.f;
#pragma unroll
                for (int kk = 0; kk < 4; ++kk) st[qt] = __builtin_amdgcn_mfma_f32_32x32x16_bf16(kf[kk], qf[qt][kk], st[qt], 0, 0, 0);
            }
            if (tile + 1 < 18) { const bf16_t* kp = Kb + (size_t)(b * TT + kt0 + 32 + pi) * DM + h * 64 + hi * 8;
#pragma unroll
                for (int kk = 0; kk < 4; ++kk) kf[kk] = *(const bf16x8*)(kp + kk * 16); }
            const int relb = n * 64 + r32 - kt0 - 8 * hi;
            const bool far = (n * 64 - kt0 - 31) >= 256;
            const float bfar = tab[512];
#pragma unroll
            for (int qt = 0; qt < 2; ++qt) {
                float mx = -1e30f;
                if (far) {
#pragma unroll
                    for (int r = 0; r < 16; ++r) { const float sv = st[qt][r] + bfar; st[qt][r] = sv; mx = fmaxf(mx, sv); }
                } else {
#pragma unroll
                    for (int r = 0; r < 16; ++r) { int rel = relb + qt * 32 - (16 * (r >> 3) + (r & 7)); rel = rel < -256 ? -256 : (rel > 256 ? 256 : rel); const float sv = st[qt][r] + tab[rel + 256]; st[qt][r] = sv; mx = fmaxf(mx, sv); }
                }
                mx = fmaxf(mx, __shfl_xor(mx, 32));
                const float mnew = fmaxf(mrow[qt], mx);
                if (__any(mnew > mrow[qt])) {
                    const float alpha = __builtin_amdgcn_exp2f(mrow[qt] - mnew); mrow[qt] = mnew; lrow[qt] *= alpha;
#pragma unroll
                    for (int dt = 0; dt < 2; ++dt)
#pragma unroll
                        for (int r = 0; r < 16; ++r) ot[dt][qt][r] *= alpha;
                }
                float ps = 0.f;
#pragma unroll
                for (int r = 0; r < 16; ++r) { const float p = __builtin_amdgcn_exp2f(st[qt][r] - mnew); st[qt][r] = p; ps += p; }
                lrow[qt] += ps;
            }
#pragma unroll
            for (int qt = 0; qt < 2; ++qt)
#pragma unroll
                for (int mm = 0; mm < 2; ++mm) {
                    u32x4 pw; pw.x = cvt_pk_bf16(st[qt][8 * mm + 0], st[qt][8 * mm + 1]); pw.y = cvt_pk_bf16(st[qt][8 * mm + 2], st[qt][8 * mm + 3]);
                    pw.z = cvt_pk_bf16(st[qt][8 * mm + 4], st[qt][8 * mm + 5]); pw.w = cvt_pk_bf16(st[qt][8 * mm + 6], st[qt][8 * mm + 7]);
                    const bf16x8 pb = __builtin_bit_cast(bf16x8, pw);
#pragma unroll
                    for (int dt = 0; dt < 2; ++dt) ot[dt][qt] = __builtin_amdgcn_mfma_f32_32x32x16_bf16(vf[dt][mm], pb, ot[dt][qt], 0, 0, 0);
                }
        }
#pragma unroll
        for (int qt = 0; qt < 2; ++qt) {
            const float l = lrow[qt] + __shfl_xor(lrow[qt], 32); const float inv = 1.0f / l;
            bf16_t* O = Ob + (size_t)(b * TT + n * 64 + qt * 32 + r32) * DM + h * 64 + 4 * hi;
#pragma unroll
            for (int dt = 0; dt < 2; ++dt)
#pragma unroll
                for (int g = 0; g < 4; ++g) { f32x4 o = {ot[dt][qt][4 * g] * inv, ot[dt][qt][4 * g + 1] * inv, ot[dt][qt][4 * g + 2] * inv, ot[dt][qt][4 * g + 3] * inv}; *(u32x2*)(O + dt * 32 + 8 * g) = pack4(o); }
        }
    }
}

#define XB_TMO      128
#define XB_XCNT(j)  (256  + 64 * (j))
#define XB_XSUB(j)  (1280 + 64 * (j))
#define XB_XGEN(j)  (2304 + 64 * (j))
#define XB_TOP      3328
#define XB_TOPGEN   3392
#define XCD_BAR_WORDS 3456
#define XB_SPIN_CAP (1u << 18)
__device__ __forceinline__ unsigned xb_ld(unsigned* p)              { return __hip_atomic_load(p, __ATOMIC_RELAXED, __HIP_MEMORY_SCOPE_AGENT); }
__device__ __forceinline__ unsigned xb_add(unsigned* p, unsigned v) { return __hip_atomic_fetch_add(p, v, __ATOMIC_RELAXED, __HIP_MEMORY_SCOPE_AGENT); }
__device__ __forceinline__ unsigned xb_xcc_id() { return (unsigned)__builtin_amdgcn_s_getreg((3 << 11) | 20) & 0xFu; }
#define XB_SPIN(cond, bar) do { unsigned _sp = 0; while (cond) { __builtin_amdgcn_s_sleep(1); \
    if ((++_sp & 255u) == 0u) { if (xb_ld(&(bar)[XB_TMO])) break; if (_sp > XB_SPIN_CAP) { atomicAdd(&(bar)[XB_TMO], 1u); break; } } } } while (0)
struct XcdBarrier { unsigned* bar; unsigned x; volatile LAS unsigned* st; };
__device__ __forceinline__ XcdBarrier xcd_barrier_post(unsigned* bar, volatile LAS unsigned* st) {
    XcdBarrier b; b.bar = bar; b.x = xb_xcc_id(); b.st = st;
    if (threadIdx.x == 0) (void)xb_add(&bar[XB_XCNT(b.x)], 1u);
    return b;
}
__device__ __forceinline__ void xcd_barrier_complete(unsigned* bar, unsigned x, unsigned& nloc, unsigned& nx) {
    const unsigned G = gridDim.x * gridDim.y * gridDim.z;
    unsigned sum, cnt, mine, sp = 0u;
    for (;;) {
        sum = 0u; cnt = 0u; mine = 0u;
#pragma unroll
        for (unsigned j = 0; j < 16; ++j) { const unsigned c = xb_ld(&bar[XB_XCNT(j)]); sum += c; cnt += (c > 0u) ? 1u : 0u; mine = (j == x) ? c : mine; }
        if (sum == G) break;
        __builtin_amdgcn_s_sleep(1);
        if ((++sp & 255u) == 0u) { if (xb_ld(&bar[XB_TMO])) break; if (sp > XB_SPIN_CAP) { atomicAdd(&bar[XB_TMO], 1u); break; } }
    }
    nloc = mine > 0u ? mine : 1u; nx = cnt > 0u ? cnt : 1u;
}
__device__ __forceinline__ void xcd_barrier(const XcdBarrier& b) {
    asm volatile("s_waitcnt vmcnt(0)" ::: "memory");
    __syncthreads();
    if (threadIdx.x == 0) {
        unsigned* bar = b.bar;
        __builtin_amdgcn_s_waitcnt(0);
        unsigned nloc = b.st[0], nx = b.st[1];
        if (nloc == 0u) { xcd_barrier_complete(bar, b.x, nloc, nx); b.st[0] = nloc; b.st[1] = nx; }
        const unsigned old = xb_add(&bar[XB_XSUB(b.x)], 1u);
        const unsigned gen = old / nloc;
        if (old + 1u == (gen + 1u) * nloc) {
            __builtin_amdgcn_fence(__ATOMIC_RELEASE, "agent");
            asm volatile("s_waitcnt vmcnt(0)" ::: "memory");
            const unsigned og = xb_add(&bar[XB_TOP], 1u);
            const unsigned tg = og / nx;
            if (og + 1u == (tg + 1u) * nx) xb_add(&bar[XB_TOPGEN], 1u);
            else XB_SPIN(xb_ld(&bar[XB_TOPGEN]) == tg, bar);
            __builtin_amdgcn_fence(__ATOMIC_ACQUIRE, "agent");
            xb_add(&bar[XB_XGEN(b.x)], 1u);
            asm volatile("s_waitcnt vmcnt(0)" ::: "memory");
        } else {
            XB_SPIN(xb_ld(&bar[XB_XGEN(b.x)]) == gen, bar);
            __builtin_amdgcn_fence(__ATOMIC_ACQUIRE, "agent");
            asm volatile("s_waitcnt vmcnt(0)" ::: "memory");
        }
    }
    __syncthreads();
}

__global__ void __launch_bounds__(512, 2) fwd_megakernel(Args a) {
    extern __shared__ __attribute__((aligned(16))) unsigned char lds_raw[];
    LAS unsigned char* lds = (LAS unsigned char*)lds_raw;
    cg::grid_group grid = cg::this_grid();
    const int G = gridDim.x, cidx = blockIdx.x;
    if (threadIdx.x < 64) ((LAS unsigned*)(lds + LDS_BYTES - 256))[threadIdx.x] = 0u;
    __syncthreads();
    const XcdBarrier bar = xcd_barrier_post((unsigned*)(a.ws + WS_BAR), (volatile LAS unsigned*)(lds + LDS_BYTES - 256));
#ifndef PHM
#define PHM 0xFFFF
#endif
#define ON(k) ((PHM >> (k)) & 1)
#ifndef REPM
#define REPM 0
#endif
#define REP(k) for (int rep_ = 0; rep_ < 1 + ((REPM >> (k)) & 1); ++rep_)
#define GSYNC() do { xcd_barrier(bar); if ((REPM >> 14) & 1) xcd_barrier(bar); } while (0)
    REP(0) if (ON(0)) phase0(a, lds, rep_ == 0);
    if (a.ws == nullptr) grid.sync();
    GSYNC();
    REP(1) if (ON(1)) phase_mix(a, lds);
    GSYNC();
    REP(2) if (ON(2)) { unsigned char* ws = launder(a.ws); SchedP2 S{(const char*)(ws + WS_AX6), (const char*)(ws + WB_RKV), G, cidx}; EpiP2 E{(bf16_t*)(ws + WS_RKV), (bf16_t*)(ws + WS_A2)};
      pg8::gemm_phase(lds, DM, DM, S, E); }
    GSYNC();
    REP(3) if (ON(3)) { unsigned char* ws = launder(a.ws); EpiP3 E{(float*)(ws + WS_DEC), a.in[13], a.in[16], 0};
      { SchedSimple S{(const char*)(ws + WS_A2), (const char*)(ws + WB_L2), 32, 8, (size_t)256 * 512 * 2, G, cidx}; E.kind = 0; pg8::gemm_phase(lds, 128, 512, S, E); }
      { SchedSimple S{(const char*)(ws + WS_A2) + 64 * 2, (const char*)(ws + WB_L2) + (size_t)2048 * 512 * 2 + 64 * 2, 32, 8, (size_t)256 * 512 * 2, G, cidx}; E.kind = 1; pg8::gemm_phase(lds, 128, 512, S, E); }
      { SchedSimple S{(const char*)(ws + WS_A2) + 192 * 2, (const char*)(ws + WB_L2) + (size_t)4096 * 512 * 2 + 192 * 2, 32, 8, (size_t)256 * 512 * 2, G, cidx}; E.kind = 2; pg8::gemm_phase(lds, 256, 512, S, E); } }
    GSYNC();
    REP(4) if (ON(4)) phase_scan(a, lds);
    GSYNC();
    REP(5) if (ON(5)) phase_gn(a, lds);
    GSYNC();
    for (int l = 0; l < 2; ++l) {
        if (l == 1) {
            REP(6) if (ON(6)) { unsigned char* ws = launder(a.ws); const float* mod1 = (const float*)(ws + WS_CTL) + 4 * 12288; const float* modkv = mod1 + 4 * 12288;
              phase_norm(lds, (const void*)(ws + WS_X2), false, a.in[31], modkv + 2048, modkv, 4096, (bf16_t*)(ws + WS_Y), a.in[4] + DM, mod1 + 2048, mod1, 12288, (bf16_t*)(ws + WS_Y) + MD, nullptr, nullptr); }
            GSYNC();
            REP(7) if (ON(7)) { unsigned char* ws = launder(a.ws); SchedP11 S{(const char*)(ws + WS_Y), (const char*)(ws + WS_Y) + MD * 2, (const char*)(ws + WB_KVQ), G, cidx}; EpiP11 E{(bf16_t*)(ws + WS_KB)};
              pg8::gemm_phase(lds, DM, DM, S, E); }
            GSYNC();
            REP(8) if (ON(8)) phase_attn(a, lds);
            GSYNC();
        }
        REP(9) if (ON(9)) { unsigned char* ws = launder(a.ws); const float* mod = (const float*)(ws + WS_CTL) + (size_t)l * 4 * 12288; const void* xin = l == 0 ? (const void*)a.in[0] : (const void*)(ws + WS_X2);
          const char* Ain = l == 0 ? (const char*)(ws + WS_YG) : (const char*)(ws + WS_KB) + 3 * MD * 2; const char* Bin = l == 0 ? (const char*)(ws + WB_O) : (const char*)(ws + WB_AO);
          SchedSimple S{Ain, Bin, 32, 8, (size_t)256 * DM * 2, G, cidx}; EpiRes E{xin, l == 0 ? 1 : 0, mod + 4096, (void*)(ws + WS_X1), 0};
          pg8::gemm_phase(lds, DM, DM, S, E); }
        GSYNC();
        REP(10) if (ON(10)) { unsigned char* ws = launder(a.ws); const float* mod = (const float*)(ws + WS_CTL) + (size_t)l * 4 * 12288;
          phase_norm(lds, (const void*)(ws + WS_X1), false, a.in[5] + l * DM, mod + 8192, mod + 6144, 12288, (bf16_t*)(ws + WS_H2), nullptr, nullptr, nullptr, 0, nullptr, nullptr, nullptr); }
        GSYNC();
        REP(11) if (ON(11)) { unsigned char* ws = launder(a.ws); SchedSimple S{(const char*)(ws + WS_H2), (const char*)(ws + WB_UP + (size_t)l * 32 * MiB), 32, 32, (size_t)256 * DM * 2, G, cidx}; EpiUp E{(bf16_t*)(ws + WS_U)};
          pg8::gemm_phase(lds, DM, DM, S, E); }
        GSYNC();
        REP(12) if (ON(12)) { unsigned char* ws = launder(a.ws); const float* mod = (const float*)(ws + WS_CTL) + (size_t)l * 4 * 12288;
          SchedSimple S{(const char*)(ws + WS_U), (const char*)(ws + WB_DN + (size_t)l * 32 * MiB), 32, 8, (size_t)256 * FF * 2, G, cidx}; EpiRes E{(const void*)(ws + WS_X1), 0, mod + 10240, (void*)(ws + WS_X2), 0};
          pg8::gemm_phase(lds, FF, FF, S, E); }
        GSYNC();
    }
    REP(13) if (ON(13)) { unsigned char* ws = launder(a.ws); phase_norm(lds, (const void*)(ws + WS_X2), false, nullptr, nullptr, nullptr, 0, nullptr, nullptr, nullptr, nullptr, 0, nullptr, a.in[34], a.out); }
}

extern "C" void kernel_launch(void* const* d_in, const int* in_sizes, int n_in, void* d_out, int out_size, void* d_ws, size_t ws_size, hipStream_t stream) {
    static int grid = 0;
    if (grid == 0) {
        if (n_in != 35 || ws_size < WS_END) { fprintf(stderr, "kernel_launch: unexpected n_in %d / ws %zu\n", n_in, ws_size); grid = -1; return; }
        int dev = 0, cus = 0, per_cu = 0;
        hipGetDevice(&dev); hipDeviceGetAttribute(&cus, hipDeviceAttributeMultiprocessorCount, dev);
        hipFuncSetAttribute((const void*)fwd_megakernel, hipFuncAttributeMaxDynamicSharedMemorySize, LDS_BYTES);
        hipOccupancyMaxActiveBlocksPerMultiprocessor(&per_cu, (const void*)fwd_megakernel, 512, LDS_BYTES);
        if (per_cu < 1) { fprintf(stderr, "kernel_launch: occupancy query says %d blocks/CU\n", per_cu); per_cu = 1; }
        (void)hipGetLastError();
        grid = cus;
    }
    if (grid < 0) return;
    hipMemsetAsync((char*)d_ws + WS_BAR, 0, 16384, stream);
    Args a{};
    for (int i = 0; i < 35; ++i) a.in[i] = (const float*)d_in[i];
    a.out = (float*)d_out; a.ws = (unsigned char*)d_ws;
    void* args[] = {&a};
    hipError_t e = hipLaunchCooperativeKernel((const void*)fwd_megakernel, dim3(grid), dim3(512), args, LDS_BYTES, stream);
    if (e != hipSuccess) fprintf(stderr, "cooperative launch failed: %s (grid %d)\n", hipGetErrorString(e), grid);
}
```

```cpp
#include <hip/hip_runtime.h>
#include <hip/hip_cooperative_groups.h>
#include <cstdio>
#include <cstdint>
namespace cg = cooperative_groups;

#define LAS __attribute__((address_space(3)))
typedef unsigned short bf16_t;
typedef short bf16x8 __attribute__((ext_vector_type(8)));
typedef float f32x2 __attribute__((ext_vector_type(2)));
typedef float f32x4 __attribute__((ext_vector_type(4)));
typedef float f32x16 __attribute__((ext_vector_type(16)));
typedef unsigned u32x2 __attribute__((ext_vector_type(2)));
typedef unsigned u32x4 __attribute__((ext_vector_type(4)));

constexpr int DM = 2048, NB = 4, TT = 2048, MTOK = NB * TT, NH = 32, FF = 8192;
constexpr float RMS_EPS = 1e-6f, GN_EPS = 64e-5f;
constexpr float LOG2E = 1.4426950408889634f;
constexpr float QSCALE = 0.125f * LOG2E;
constexpr size_t MD = (size_t)MTOK * DM;

constexpr size_t MiB = 1u << 20;
constexpr size_t WB_RKV = 0;
constexpr size_t WB_L2 = 48 * MiB;
constexpr size_t WB_O = 54 * MiB;
constexpr size_t WB_UP = 62 * MiB;
constexpr size_t WB_DN = 126 * MiB;
constexpr size_t WB_KVQ = 190 * MiB;
constexpr size_t WB_AO = 214 * MiB;
constexpr size_t WS_CTL = 222 * MiB;
constexpr size_t MOD_BYTES = (size_t)(2 * 4 * 12288 + 4 * 4096) * 4;
constexpr size_t WS_BAR = WS_CTL + MOD_BYTES;
constexpr size_t CTL_BYTES = MOD_BYTES + 16384;
constexpr size_t RA = 224 * MiB;
constexpr size_t RB = 416 * MiB;
constexpr size_t RC = 608 * MiB;
constexpr size_t WS_AX6 = RA;
constexpr size_t WS_DEC = RA;
constexpr size_t WS_X1 = RA;
constexpr size_t WS_H2 = RA + 64 * MiB;
constexpr size_t WS_X2 = RA + 96 * MiB;
constexpr size_t WS_X4 = RA + 128 * MiB;
constexpr size_t WS_RKV = RB;
constexpr size_t WS_U = RB;
constexpr size_t WS_KB = RB;
constexpr size_t WS_A2 = RC;
constexpr size_t WS_Y = RC + 8 * MiB;
constexpr size_t WS_BON = RC + 72 * MiB;
constexpr size_t WS_YG = RC + 73 * MiB;
constexpr size_t WS_PARTS = RC + 105 * MiB;
constexpr size_t WS_PART0 = WS_CTL + 512 * 1024;
constexpr size_t WS_END = RC + 107 * MiB;

constexpr int LDS_BYTES = 147456;

__device__ __forceinline__ unsigned cvt_pk_bf16(float lo, float hi) { unsigned r; asm volatile("v_cvt_pk_bf16_f32 %0, %1, %2" : "=v"(r) : "v"(lo), "v"(hi)); return r; }
__device__ __forceinline__ u32x2 pack4(f32x4 v) { u32x2 w; w.x = cvt_pk_bf16(v[0], v[1]); w.y = cvt_pk_bf16(v[2], v[3]); return w; }
template <int CTRL> __device__ __forceinline__ float dppmov(float v) { return __builtin_bit_cast(float, __builtin_amdgcn_update_dpp(0, __builtin_bit_cast(int, v), CTRL, 0xF, 0xF, true)); }
__device__ __forceinline__ float allreduce16(float v) {
    v += dppmov<0xB1>(v); v += dppmov<0x4E>(v); v += dppmov<0x141>(v); v += dppmov<0x140>(v); return v;
}
template <int CTRL> __device__ __forceinline__ float dppmov1(float v) { return __builtin_bit_cast(float, __builtin_amdgcn_update_dpp(0x3f800000, __builtin_bit_cast(int, v), CTRL, 0xF, 0xF, false)); }
__device__ __forceinline__ float scanmul16(float v) { v *= dppmov1<0x111>(v); v *= dppmov1<0x112>(v); v *= dppmov1<0x114>(v); v *= dppmov1<0x118>(v); return v; }
__device__ __forceinline__ float allmul16(float v) { v *= dppmov<0xB1>(v); v *= dppmov<0x4E>(v); v *= dppmov<0x141>(v); v *= dppmov<0x140>(v); return v; }
__device__ __forceinline__ float allreduce64(float v) { v = allreduce16(v); v += __shfl_xor(v, 16); v += __shfl_xor(v, 32); return v; }
__device__ __forceinline__ float fma_s(float a, float b, float c) { float r; asm("v_fma_f32 %0, %1, %2, %3" : "=v"(r) : "v"(a), "v"(b), "v"(c)); return r; }
__device__ __forceinline__ float mul_s(float a, float b) { float r; asm("v_mul_f32 %0, %1, %2" : "=v"(r) : "v"(a), "v"(b)); return r; }
__device__ __forceinline__ float add_s(float a, float b) { float r; asm("v_add_f32 %0, %1, %2" : "=v"(r) : "v"(a), "v"(b)); return r; }
__device__ __forceinline__ f32x4 ldbf4(const bf16_t* p) { const u32x2 w = *(const u32x2*)p; f32x4 r; r[0] = __builtin_bit_cast(float, w.x << 16); r[1] = __builtin_bit_cast(float, w.x & 0xffff0000u); r[2] = __builtin_bit_cast(float, w.y << 16); r[3] = __builtin_bit_cast(float, w.y & 0xffff0000u); return r; }
__device__ __forceinline__ f32x4 cvt4(u32x2 w) { f32x4 r; r[0] = __builtin_bit_cast(float, w.x << 16); r[1] = __builtin_bit_cast(float, w.x & 0xffff0000u); r[2] = __builtin_bit_cast(float, w.y << 16); r[3] = __builtin_bit_cast(float, w.y & 0xffff0000u); return r; }
__device__ __forceinline__ float sum4(f32x4 v) { return (v[0] + v[1]) + (v[2] + v[3]); }
__device__ __forceinline__ float dot4(f32x4 a, f32x4 b) { return (a[0] * b[0] + a[1] * b[1]) + (a[2] * b[2] + a[3] * b[3]); }

__device__ __forceinline__ unsigned char* launder(unsigned char* p) { unsigned lo = (unsigned)(uintptr_t)p, hi = (unsigned)((uintptr_t)p >> 32); asm volatile("" : "+v"(lo), "+v"(hi));
    lo = __builtin_amdgcn_readfirstlane(lo); hi = __builtin_amdgcn_readfirstlane(hi); return (unsigned char*)(__attribute__((address_space(1))) unsigned char*)(((uintptr_t)hi << 32) | (uintptr_t)lo); }
__device__ __forceinline__ int launder_tid() { int t = threadIdx.x; asm volatile("" : "+v"(t)); return t; }

namespace pg8 {
constexpr int BM = 256, BK = 64, HALF = 128, HTB = HALF * BK * 2, STAGE_BYTES = 8 * HTB, NXCD = 8, WGM = 4;
__host__ __device__ __forceinline__ int lds_byte(int r, int c) { const int st = (r >> 4) * 2 + (c >> 5), rr = r & 15, cc = c & 31, ob = rr * 64 + cc * 2; return st * 1024 + (ob ^ (((ob >> 9) & 1) << 5)); }
__host__ __device__ __forceinline__ void stage_rc(int b, int& R, int& C) { const int st = b / 1024, sb = b % 1024, swz = sb ^ (((sb >> 9) & 1) << 5); R = (st >> 1) * 16 + swz / 64; C = (st & 1) * 32 + (swz % 64) / 2; }

struct Unit { int pm, pn, prob, half; const char* A; const char* B; };

__device__ __forceinline__ void tile_order(int nM, int nN, int wgid, int& pm, int& pn) {
    const int nwg = nM * nN; { const int q = nwg / NXCD, r = nwg % NXCD, xcd = wgid % NXCD, off = wgid / NXCD; wgid = (xcd < r ? xcd * (q + 1) : r * (q + 1) + (xcd - r) * q) + off; }
    const int nig = WGM * nN, gid = wgid / nig, fm = gid * WGM, gsz = (nM - fm) < WGM ? (nM - fm) : WGM;
    pm = fm + ((wgid % nig) % gsz); pn = (wgid % nig) / gsz;
}

template <class Epi, class Sched>
__device__ __forceinline__ void gemm_phase(LAS unsigned char* lds, const int K, const int ld, const Sched& S, const Epi& E) {
    const int tid = launder_tid(), wid = __builtin_amdgcn_readfirstlane(tid >> 6), lane = tid & 63, wr = wid >> 2, wc = wid & 3; int fr = lane & 15, fq = lane >> 4;
    const int nt = K / BK;
    unsigned voffA[2], voffB[2];
#pragma unroll
    for (int i = 0; i < 2; ++i) { int R, C; stage_rc(tid * 16 + i * 8192, R, C); const int rho = R & 31, Rb = (R & ~31) + 8 * ((rho & 15) >> 2) + 4 * (rho >> 4) + (rho & 3);
        voffA[i] = (unsigned)(R * ld + C) * 2u; voffB[i] = (unsigned)(Rb * ld + C) * 2u; }
    const size_t kstep = (size_t)(BK * 2);
    const size_t hstep = (size_t)HALF * ld * 2;
    const unsigned ldsw = (unsigned)wid * 1024u;
    const int aoff = lds_byte(wr * 64 + fr, fq * 8), boff = lds_byte(wc * 32 + fr, fq * 8);
#define PG8_SA(b, h) (((b) * 2 + (h)) * HTB)
#define PG8_SB(b, h) ((4 + (b) * 2 + (h)) * HTB)
#define PG8_STAGE(bufoff, gbase, voff) do { _Pragma("unroll") for (int _i = 0; _i < 2; ++_i) \
        __builtin_amdgcn_global_load_lds((const unsigned*)((const char*)(gbase) + (voff)[_i]), (LAS unsigned*)(lds + (bufoff) + ldsw + _i * 8192), 16, 0, 0); } while (0)
#define PG8_LDA(dst, b, h) do { _Pragma("unroll") for (int m = 0; m < 4; ++m) _Pragma("unroll") for (int k = 0; k < 2; ++k) dst[m][k] = *(const LAS bf16x8*)(lds + PG8_SA(b, h) + aoff + m * 2048 + k * 1024); } while (0)
#define PG8_LDB(dst, b, h) do { _Pragma("unroll") for (int n = 0; n < 2; ++n) _Pragma("unroll") for (int k = 0; k < 2; ++k) dst[n][k] = *(const LAS bf16x8*)(lds + PG8_SB(b, h) + boff + n * 2048 + k * 1024); } while (0)
#define PG8_MMA(ai, bj, At, Bt) do { __builtin_amdgcn_s_setprio(1); _Pragma("unroll") for (int m = 0; m < 4; ++m) _Pragma("unroll") for (int n = 0; n < 2; ++n) _Pragma("unroll") for (int k = 0; k < 2; ++k) \
        acc[ai][bj][m][n] = __builtin_amdgcn_mfma_f32_16x16x32_bf16(Bt[n][k], At[m][k], acc[ai][bj][m][n], 0, 0, 0); __builtin_amdgcn_s_setprio(0); } while (0)
#define PG8_WAIT_V(n) asm volatile("s_waitcnt vmcnt(" #n ")" ::: "memory")
#define PG8_WAIT_L(n) asm volatile("s_waitcnt lgkmcnt(" #n ")" ::: "memory")
#define PG8_BAR __builtin_amdgcn_s_barrier()
#define PG8_SCHED __builtin_amdgcn_sched_barrier(0)
    Unit cur, nxt; int ui = 0;
    if (!S.next(0, cur)) return;
    f32x4 acc[2][2][4][2];
#pragma unroll
    for (int a = 0; a < 2; ++a)
#pragma unroll
        for (int b = 0; b < 2; ++b)
#pragma unroll
            for (int m = 0; m < 4; ++m)
#pragma unroll
                for (int n = 0; n < 2; ++n) acc[a][b][m][n] = (f32x4){0.f, 0.f, 0.f, 0.f};
    bf16x8 At[4][2], B0[2][2], B1[2][2];
    const char* cA = cur.A; const char* cB = cur.B;
    PG8_STAGE(PG8_SB(0, 0), cB, voffB); PG8_STAGE(PG8_SB(0, 1), cB + hstep, voffB); PG8_STAGE(PG8_SA(0, 0), cA, voffA); PG8_STAGE(PG8_SA(0, 1), cA + hstep, voffA);
    if (wr == 1) PG8_BAR;
    PG8_WAIT_V(2); PG8_BAR;
    PG8_STAGE(PG8_SB(1, 0), cB + kstep, voffB); PG8_STAGE(PG8_SA(1, 0), cA + kstep, voffA); PG8_STAGE(PG8_SB(1, 1), cB + hstep + kstep, voffB);
    PG8_WAIT_V(6); PG8_BAR;
    for (;;) {
        const bool has_next = S.next(ui + 1, nxt); const bool full = cur.half == 0;
        const char* nA = has_next ? nxt.A : cA; const char* nB = has_next ? nxt.B : cB;
        for (int t = 0; t < nt; t += 2) {
            const bool last = (t == nt - 2);
            const char* a1 = cA + (size_t)(t + 1) * kstep;
            const char* a2 = last ? nA : cA + (size_t)(t + 2) * kstep; const char* b2 = last ? nB : cB + (size_t)(t + 2) * kstep;
            const char* a3 = a2 + kstep; const char* b3 = b2 + kstep;
            PG8_LDB(B0, 0, 0); PG8_LDB(B1, 0, 1); PG8_SCHED; PG8_LDA(At, 0, 0); PG8_STAGE(PG8_SA(1, 1), a1 + hstep, voffA);
            PG8_WAIT_V(8); PG8_WAIT_L(0); PG8_BAR; PG8_MMA(0, 0, At, B0); if (full) PG8_MMA(0, 1, At, B1); PG8_BAR; PG8_SCHED;
            PG8_LDA(At, 0, 1); PG8_STAGE(PG8_SB(0, 0), b2, voffB); PG8_STAGE(PG8_SB(0, 1), b2 + hstep, voffB); PG8_STAGE(PG8_SA(0, 0), a2, voffA);
            PG8_WAIT_V(8); PG8_WAIT_L(0); PG8_BAR; PG8_MMA(1, 0, At, B0); if (full) PG8_MMA(1, 1, At, B1); PG8_BAR; PG8_SCHED;
            PG8_LDB(B0, 1, 0); PG8_LDB(B1, 1, 1); PG8_SCHED; PG8_LDA(At, 1, 0); PG8_STAGE(PG8_SA(0, 1), a2 + hstep, voffA);
            PG8_WAIT_V(8); PG8_WAIT_L(0); PG8_BAR; PG8_MMA(0, 0, At, B0); if (full) PG8_MMA(0, 1, At, B1); PG8_BAR; PG8_SCHED;
            PG8_LDA(At, 1, 1); PG8_STAGE(PG8_SB(1, 0), b3, voffB); PG8_STAGE(PG8_SB(1, 1), b3 + hstep, voffB); PG8_STAGE(PG8_SA(1, 0), a3, voffA);
            PG8_WAIT_V(8); PG8_WAIT_L(0); PG8_BAR; PG8_MMA(1, 0, At, B0); if (full) PG8_MMA(1, 1, At, B1); PG8_BAR; PG8_SCHED;
        }
        if (wr == 0) PG8_BAR;
        E(acc, cur, wr, wc, fr, fq);
#ifdef EPI2
        E(acc, cur, wr, wc, fr, fq);
#endif
        if (!has_next) break;
#pragma unroll
        for (int a = 0; a < 2; ++a)
#pragma unroll
            for (int b = 0; b < 2; ++b)
#pragma unroll
                for (int m = 0; m < 4; ++m)
#pragma unroll
                    for (int n = 0; n < 2; ++n) acc[a][b][m][n] = (f32x4){0.f, 0.f, 0.f, 0.f};
        cur = nxt; cA = nA; cB = nB; ++ui;
        if (wr == 1) PG8_BAR;
    }
    PG8_WAIT_V(0);
    PG8_BAR;
#undef PG8_SA
#undef PG8_SB
#undef PG8_STAGE
#undef PG8_LDA
#undef PG8_LDB
#undef PG8_MMA
#undef PG8_WAIT_V
#undef PG8_WAIT_L
#undef PG8_BAR
#undef PG8_SCHED
}
}
using pg8::Unit;

struct SchedSimple {
    const char* A; const char* Bt; int nM, nN; size_t tstep; int G, c;
    __device__ __forceinline__ bool next(int i, Unit& u) const {
        const int L = i * G + c; if (L >= nM * nN) return false;
        pg8::tile_order(nM, nN, L, u.pm, u.pn); u.prob = 0; u.half = 0; u.A = A + (size_t)u.pm * tstep; u.B = Bt + (size_t)u.pn * tstep; return true;
    }
};
struct SchedP2 {
    const char* A0; const char* B0; int G, c;
    __device__ __forceinline__ bool next(int i, Unit& u) const {
        const int L = i * G + c; if (L >= 896) return false;
        const size_t tstep = (size_t)256 * DM * 2;
        if (L < 768) { u.prob = L >> 8; u.half = 0; pg8::tile_order(32, 8, L & 255, u.pm, u.pn); u.A = A0 + (size_t)u.prob * (MD * 2) + (size_t)u.pm * tstep; u.B = B0 + (size_t)u.prob * (8 * MiB) + (size_t)u.pn * tstep; }
        else { const int l = L - 768; u.prob = 3 + (l >> 5); u.half = 1; u.pm = l & 31; u.pn = 0; const int slot = u.prob > 5 ? 5 : u.prob;
            u.A = A0 + (size_t)slot * (MD * 2) + (size_t)u.pm * tstep; u.B = B0 + (size_t)slot * (8 * MiB) + (u.prob == 6 ? (size_t)128 * DM * 2 : 0); }
        return true;
    }
};
struct SchedP11 {
    const char* HKV; const char* HQ; const char* W; int G, c;
    __device__ __forceinline__ bool next(int i, Unit& u) const {
        const int L = i * G + c; if (L >= 768) return false;
        const size_t tstep = (size_t)256 * DM * 2;
        u.prob = L >> 8; u.half = 0;
        if (u.prob == 1) { pg8::tile_order(8, 32, L & 255, u.pm, u.pn); u.A = W + 8 * MiB + (size_t)u.pm * tstep; u.B = HKV + (size_t)u.pn * tstep; }
        else { pg8::tile_order(32, 8, L & 255, u.pm, u.pn); u.A = (u.prob == 0 ? HKV : HQ) + (size_t)u.pm * tstep; u.B = W + (size_t)u.prob * (8 * MiB) + (size_t)u.pn * tstep; }
        return true;
    }
};

#define EPI_LOOP_BEGIN(LD) asm volatile("" : "+v"(fr), "+v"(fq)); _Pragma("unroll") for (int ai = 0; ai < 2; ++ai) _Pragma("unroll") for (int m = 0; m < 4; ++m) { const unsigned ro = (unsigned)(ai * 128 + wr * 64 + m * 16 + fr) * (unsigned)(LD); \
    _Pragma("unroll") for (int bj = 0; bj < 2; ++bj) { const int cl = bj * 128 + wc * 32 + fq * 8; const unsigned off = ro + (unsigned)cl; const f32x4 v0 = acc[ai][bj][m][0], v1 = acc[ai][bj][m][1];
#define EPI_LOOP_END } asm volatile("" ::: "memory"); }
__device__ __forceinline__ u32x4 pack8(f32x4 a, f32x4 b) { u32x4 w; w.x = cvt_pk_bf16(a[0], a[1]); w.y = cvt_pk_bf16(a[2], a[3]); w.z = cvt_pk_bf16(b[0], b[1]); w.w = cvt_pk_bf16(b[2], b[3]); return w; }
__device__ __forceinline__ void ldbf8(const bf16_t* p, f32x4& a, f32x4& b) { const u32x4 w = *(const u32x4*)p; a = cvt4((u32x2){w.x, w.y}); b = cvt4((u32x2){w.z, w.w}); }
__device__ __forceinline__ f32x4 sig4(f32x4 x) { f32x4 o;
#pragma unroll
    for (int j = 0; j < 4; ++j) o[j] = 1.0f / (1.0f + __expf(-x[j]));
    return o; }

struct EpiP2 {
    bf16_t* RKV; bf16_t* A2;
    __device__ __forceinline__ void operator()(const f32x4 (&acc)[2][2][4][2], const Unit& u, int wr, int wc, int fr, int fq) const {
        if (u.prob < 3) {
            bf16_t* O = RKV + (size_t)u.prob * MD + (size_t)(u.pm * 256) * DM + u.pn * 256;
            EPI_LOOP_BEGIN(DM) *(u32x4*)(O + off) = pack8(v0, v1); EPI_LOOP_END
        } else if (u.prob == 3) {
            bf16_t* O = A2 + (size_t)(u.pm * 256) * 512;
            EPI_LOOP_BEGIN(512) if (cl < 96) { f32x4 o0, o1;
#pragma unroll
                for (int j = 0; j < 4; ++j) { const float e0 = __expf(2.0f * v0[j]), e1 = __expf(2.0f * v1[j]); o0[j] = 1.0f - 2.0f / (e0 + 1.0f); o1[j] = 1.0f - 2.0f / (e1 + 1.0f); }
                *(u32x4*)(O + off) = pack8(o0, o1); } EPI_LOOP_END
        } else if (u.prob == 4) {
            bf16_t* O = A2 + (size_t)(u.pm * 256) * 512 + 96;
            EPI_LOOP_BEGIN(512) if (cl < 96) { *(u32x4*)(O + off) = pack8(v0, v1); } EPI_LOOP_END
        } else {
            bf16_t* O = A2 + (size_t)(u.pm * 256) * 512 + (u.prob == 5 ? 192 : 320);
            EPI_LOOP_BEGIN(512) if (cl < 128) { *(u32x4*)(O + off) = pack8(sig4(v0), sig4(v1)); } EPI_LOOP_END
        }
    }
};
struct EpiP3 {
    float* DEC; const float* w0; const float* a0; int kind;
    __device__ __forceinline__ void operator()(const f32x4 (&acc)[2][2][4][2], const Unit& u, int wr, int wc, int fr, int fq) const {
        const int cb = u.pn * 256;
        float* O = DEC + (size_t)(u.pm * 256) * DM + cb;
        bf16_t* Ob = (bf16_t*)(DEC + MD) + (size_t)(kind - 1) * MD + (size_t)(u.pm * 256) * DM + cb;
        if (kind == 0) {
            const float* wb = w0 + cb;
            asm volatile("" : "+v"(fr), "+v"(fq));
#pragma unroll
            for (int ai = 0; ai < 2; ++ai)
#pragma unroll
                for (int bj = 0; bj < 2; ++bj) { const int cl = bj * 128 + wc * 32 + fq * 8; const f32x4 wq0 = *(const f32x4*)(wb + cl), wq1 = *(const f32x4*)(wb + cl + 4);
                    f32x4 g[4][2];
#pragma unroll
                    for (int m = 0; m < 4; ++m) { const f32x4 s0 = sig4(wq0 + acc[ai][bj][m][0]), s1 = sig4(wq1 + acc[ai][bj][m][1]);
#pragma unroll
                        for (int j = 0; j < 4; ++j) { g[m][0][j] = __expf(-0.6065306597126334f * s0[j]); g[m][1][j] = __expf(-0.6065306597126334f * s1[j]); } }
#pragma unroll
                    for (int p = 0; p < 2; ++p)
#pragma unroll
                        for (int h = 0; h < 2; ++h)
#pragma unroll
                            for (int j = 0; j < 4; ++j) { const float a_ = g[2 * p][h][j], b_ = g[2 * p + 1][h][j]; const float ta = allmul16(a_);
                                g[2 * p][h][j] = scanmul16(a_); g[2 * p + 1][h][j] = scanmul16(b_) * ta; }
#pragma unroll
                    for (int m = 0; m < 4; ++m) { const unsigned off = (unsigned)(ai * 128 + wr * 64 + m * 16 + fr) * (unsigned)DM + (unsigned)cl; *(f32x4*)(O + off) = g[m][0]; *(f32x4*)(O + off + 4) = g[m][1]; }
                    asm volatile("" ::: "memory"); }
        } else if (kind == 1) {
            const float* wb = a0 + cb;
            EPI_LOOP_BEGIN(DM) *(u32x4*)(Ob + off) = pack8(sig4(*(const f32x4*)(wb + cl) + v0), sig4(*(const f32x4*)(wb + cl + 4) + v1)); EPI_LOOP_END
        } else {
            EPI_LOOP_BEGIN(DM) *(u32x4*)(Ob + off) = pack8(v0, v1); EPI_LOOP_END
        }
    }
};
struct EpiRes {
    const void* base; int base_f32; const float* gate; void* out; int out_f32;
    __device__ __forceinline__ void operator()(const f32x4 (&acc)[2][2][4][2], const Unit& u, int wr, int wc, int fr, int fq) const {
        const int b = u.pm >> 3; const float* g = gate + (size_t)b * 12288 + u.pn * 256;
        const size_t o0 = (size_t)(u.pm * 256) * DM + u.pn * 256;
        if (base_f32) { const float* B_ = (const float*)base + o0; bf16_t* O = (bf16_t*)out + o0;
            EPI_LOOP_BEGIN(DM) const f32x4 g0 = *(const f32x4*)(g + cl), g1 = *(const f32x4*)(g + cl + 4); const f32x4 b0 = *(const f32x4*)(B_ + off), b1 = *(const f32x4*)(B_ + off + 4);
                *(u32x4*)(O + off) = pack8(b0 + g0 * v0, b1 + g1 * v1); EPI_LOOP_END
        } else if (out_f32) { const bf16_t* B_ = (const bf16_t*)base + o0; float* O = (float*)out + o0;
            EPI_LOOP_BEGIN(DM) const f32x4 g0 = *(const f32x4*)(g + cl), g1 = *(const f32x4*)(g + cl + 4); f32x4 b0, b1; ldbf8(B_ + off, b0, b1);
                *(f32x4*)(O + off) = b0 + g0 * v0; *(f32x4*)(O + off + 4) = b1 + g1 * v1; EPI_LOOP_END
        } else { const bf16_t* B_ = (const bf16_t*)base + o0; bf16_t* O = (bf16_t*)out + o0;
            EPI_LOOP_BEGIN(DM) const f32x4 g0 = *(const f32x4*)(g + cl), g1 = *(const f32x4*)(g + cl + 4); f32x4 b0, b1; ldbf8(B_ + off, b0, b1);
                *(u32x4*)(O + off) = pack8(b0 + g0 * v0, b1 + g1 * v1); EPI_LOOP_END
        }
    }
};
struct EpiUp {
    bf16_t* U;
    __device__ __forceinline__ void operator()(const f32x4 (&acc)[2][2][4][2], const Unit& u, int wr, int wc, int fr, int fq) const {
        bf16_t* O = U + (size_t)(u.pm * 256) * FF + u.pn * 256;
        EPI_LOOP_BEGIN(FF) f32x4 o0, o1;
#pragma unroll
            for (int j = 0; j < 4; ++j) { const float x0 = fmaxf(v0[j], 0.f), x1 = fmaxf(v1[j], 0.f); o0[j] = x0 * x0; o1[j] = x1 * x1; }
            *(u32x4*)(O + off) = pack8(o0, o1); EPI_LOOP_END
    }
};
struct EpiP11 {
    bf16_t* KB;
    __device__ __forceinline__ void operator()(const f32x4 (&acc)[2][2][4][2], const Unit& u, int wr, int wc, int fr, int fq) const {
        const int bb = u.pn >> 3, t0 = (u.pn & 7) * 256;
        bf16_t* O = (u.prob == 1) ? KB + MD + ((size_t)bb * 2048 + u.pm * 256) * 2048 + t0 : KB + (size_t)u.prob * MD + (size_t)(u.pm * 256) * DM + u.pn * 256;
        const float sc = u.prob == 2 ? QSCALE : 1.0f;
        EPI_LOOP_BEGIN(DM) *(u32x4*)(O + off) = pack8(v0 * sc, v1 * sc); EPI_LOOP_END
    }
};

__device__ __forceinline__ unsigned f2bf(float f) { unsigned u = __builtin_bit_cast(unsigned, f); return (u + 0x7fffu + ((u >> 16) & 1u)) >> 16; }
__device__ __forceinline__ unsigned pk2(float lo, float hi) { return f2bf(lo) | (f2bf(hi) << 16); }
__device__ __forceinline__ void transpose_item(const float* W, int K, int N, bf16_t* WT, LAS float* scr, int item, int lane) {
    const int nblk = N / 32, kb = item / nblk, nb = item % nblk, k0 = 64 * kb, n0 = 32 * nb;
#pragma unroll 8
    for (int i = 0; i < 32; ++i) { const int kk = 2 * i + (lane >> 5); scr[kk * 33 + (lane & 31)] = W[(size_t)(k0 + kk) * N + n0 + (lane & 31)]; }
    asm volatile("s_waitcnt lgkmcnt(0)" ::: "memory");
    const int c = lane & 7;
#pragma unroll
    for (int j = 0; j < 4; ++j) { const int n = (lane >> 3) + 8 * j; const LAS float* s = scr + (8 * c) * 33 + n;
        u32x4 o; o.x = pk2(s[0 * 33], s[1 * 33]); o.y = pk2(s[2 * 33], s[3 * 33]); o.z = pk2(s[4 * 33], s[5 * 33]); o.w = pk2(s[6 * 33], s[7 * 33]);
        *(u32x4*)(WT + (size_t)(n0 + n) * K + k0 + 8 * c) = o; }
    asm volatile("s_waitcnt lgkmcnt(0)" ::: "memory");
}
__device__ __forceinline__ void transpose_item64(const float* W, int K, int N, bf16_t* WT, LAS float* scr, int item, int lane) {
    const int nblk = N / 64, kb = item / nblk, nb = item % nblk, k0 = 64 * kb, n0 = 64 * nb;
    const float* src = W + (size_t)k0 * N + n0 + lane;
    float tvv[64];
#pragma unroll
    for (int i = 0; i < 64; ++i) tvv[i] = __builtin_nontemporal_load(src + (size_t)i * N);
#pragma unroll
    for (int i = 0; i < 64; ++i) scr[i * 65 + lane] = tvv[i];
    asm volatile("s_waitcnt lgkmcnt(0)" ::: "memory");
    const int c = lane & 7;
#pragma unroll
    for (int j = 0; j < 8; ++j) { const int n = (lane >> 3) + 8 * j; const LAS float* sp = scr + (8 * c) * 65 + n;
        u32x4 o; o.x = pk2(sp[0 * 65], sp[1 * 65]); o.y = pk2(sp[2 * 65], sp[3 * 65]); o.z = pk2(sp[4 * 65], sp[5 * 65]); o.w = pk2(sp[6 * 65], sp[7 * 65]);
        *(u32x4*)(WT + (size_t)(n0 + n) * K + k0 + 8 * c) = o; }
    asm volatile("s_waitcnt lgkmcnt(0)" ::: "memory");
}
__device__ __forceinline__ void transpose_item32(const float* src, int N, bf16_t* dst, int ldd, LAS float* scr, int lane) {
#pragma unroll
    for (int i = 0; i < 16; ++i) { const int kk = 2 * i + (lane >> 5); scr[kk * 33 + (lane & 31)] = src[(size_t)kk * N + (lane & 31)]; }
    asm volatile("s_waitcnt lgkmcnt(0)" ::: "memory");
    const int c = lane & 3;
#pragma unroll
    for (int j = 0; j < 2; ++j) { const int n = (lane >> 2) + 16 * j; const LAS float* sp = scr + (8 * c) * 33 + n;
        u32x4 o; o.x = pk2(sp[0 * 33], sp[1 * 33]); o.y = pk2(sp[2 * 33], sp[3 * 33]); o.z = pk2(sp[4 * 33], sp[5 * 33]); o.w = pk2(sp[6 * 33], sp[7 * 33]);
        *(u32x4*)(dst + (size_t)n * ldd + 8 * c) = o; }
    asm volatile("s_waitcnt lgkmcnt(0)" ::: "memory");
}
__device__ __forceinline__ void mod_item(const float* W, int N, int ncb, const float* bias, const float* cvec, float* part, int item, int lane) {
    const int kc = item / ncb, cb = item - kc * ncb; const int col = cb * 256 + lane * 4, k0 = kc * 128;
    f32x4 a0 = {0.f, 0.f, 0.f, 0.f}, a1 = a0, a2 = a0, a3 = a0;
    const float* wp = W + (size_t)k0 * N + col;
    for (int k8 = 0; k8 < 128; k8 += 16) {
        f32x4 w[16];
#pragma unroll
        for (int i = 0; i < 16; ++i) w[i] = __builtin_nontemporal_load((const f32x4*)(wp + (size_t)(k8 + i) * N));
#pragma unroll
        for (int i = 0; i < 16; ++i) { const int kk = k0 + k8 + i; a0 += w[i] * cvec[kk]; a1 += w[i] * cvec[DM + kk]; a2 += w[i] * cvec[2 * DM + kk]; a3 += w[i] * cvec[3 * DM + kk]; }
    }
    if (kc == 0) { const f32x4 bv = *(const f32x4*)(bias + col); a0 += bv; a1 += bv; a2 += bv; a3 += bv; }
    float* o = part + (size_t)(kc * 4) * 4096 + col;
    *(f32x4*)(o) = a0; *(f32x4*)(o + 4096) = a1; *(f32x4*)(o + 2 * 4096) = a2; *(f32x4*)(o + 3 * 4096) = a3;
}

struct Args { const float* in[35]; float* out; unsigned char* ws; };
#define TR_LOAD(tv, W, N, item) do { const int nblk_ = (N) / 32, kb_ = (item) / nblk_, nb_ = (item) % nblk_; const float* src_ = (W) + (size_t)(64 * kb_ + (lane >> 5)) * (N) + 32 * nb_ + (lane & 31); \
        _Pragma("unroll") for (int i_ = 0; i_ < 32; ++i_) tv(i_) = __builtin_nontemporal_load(src_ + (size_t)(2 * i_) * (N)); } while (0)
#define TR_STORE(tv, K, N, WT, scr, item) do { const int nblk_ = (N) / 32, kb_ = (item) / nblk_, nb_ = (item) % nblk_, k0_ = 64 * kb_, n0_ = 32 * nb_; \
        _Pragma("unroll") for (int i_ = 0; i_ < 32; ++i_) (scr)[(2 * i_ + (lane >> 5)) * 33 + (lane & 31)] = tv(i_); \
        asm volatile("s_waitcnt lgkmcnt(0)" ::: "memory"); const int c_ = lane & 7; \
        _Pragma("unroll") for (int j_ = 0; j_ < 4; ++j_) { const int n_ = (lane >> 3) + 8 * j_; const LAS float* sp_ = (scr) + (8 * c_) * 33 + n_; \
            u32x4 o_; o_.x = pk2(sp_[0 * 33], sp_[1 * 33]); o_.y = pk2(sp_[2 * 33], sp_[3 * 33]); o_.z = pk2(sp_[4 * 33], sp_[5 * 33]); o_.w = pk2(sp_[6 * 33], sp_[7 * 33]); \
            *(u32x4*)((WT) + (size_t)(n0_ + n_) * (K) + k0_ + 8 * c_) = o_; } \
        asm volatile("s_waitcnt lgkmcnt(0)" ::: "memory"); } while (0)
constexpr int LATER_ITEMS = 4 * 8192 + 4 * 2048;
__device__ __forceinline__ void later_src(const Args& a, unsigned char* ws, int slot, const float*& W, int& K, int& N, bf16_t*& WT, int& item) {
    int r = slot;
    if (r < 16384) { const int l = r >> 13; W = a.in[6] + (size_t)l * DM * FF; K = DM; N = FF; WT = (bf16_t*)(ws + WB_UP + (size_t)l * 32 * MiB); item = r & 8191; return; } r -= 16384;
    if (r < 16384) { const int l = r >> 13; W = a.in[7] + (size_t)l * DM * FF; K = FF; N = DM; WT = (bf16_t*)(ws + WB_DN + (size_t)l * 32 * MiB); item = r & 8191; return; } r -= 16384;
    K = DM; N = DM; item = r & 2047; const int q = r >> 11;
    W = q == 0 ? a.in[32] : (q == 1 ? a.in[33] : (q == 2 ? a.in[26] : a.in[27]));
    WT = (bf16_t*)(ws + (q == 3 ? WB_AO : WB_KVQ + (size_t)q * 8 * MiB));
}


__device__ __forceinline__ void phase0(const Args& a, LAS unsigned char* lds, const bool do_mod) {
    const int tid = launder_tid(), lane = tid & 63, wave = tid >> 6;
    const int gw = blockIdx.x * 8 + wave, NGW = gridDim.x * 8;
    unsigned char* ws = launder(a.ws);
    LAS float* scr = (LAS float*)(lds + wave * 16640);
    constexpr int I_SQ = 1024, I_96 = 96, I_256 = 128;
    constexpr int NITEMS = 4 * I_SQ + 2 * I_96 + I_256;
    for (int it = gw; it < NITEMS; it += NGW) {
        int r = it;
        if (r < 3 * I_SQ) { const int s = r / I_SQ; transpose_item64(s == 0 ? a.in[9] : (s == 1 ? a.in[10] : a.in[11]), DM, DM, (bf16_t*)(ws + WB_RKV + (size_t)s * 8 * MiB), scr, r % I_SQ, lane); continue; } r -= 3 * I_SQ;
        if (r < I_96) { transpose_item(a.in[14], DM, 96, (bf16_t*)(ws + WB_RKV + 3 * 8 * MiB), scr, r, lane); continue; } r -= I_96;
        if (r < I_96) { transpose_item(a.in[17], DM, 96, (bf16_t*)(ws + WB_RKV + 4 * 8 * MiB), scr, r, lane); continue; } r -= I_96;
        if (r < I_256) { transpose_item64(a.in[19], DM, 256, (bf16_t*)(ws + WB_RKV + 5 * 8 * MiB), scr, r, lane); continue; } r -= I_256;
        transpose_item64(a.in[12], DM, DM, (bf16_t*)(ws + WB_O), scr, r, lane);
    }
    { const int gt = blockIdx.x * 512 + tid, NGT = gridDim.x * 512; constexpr int PER = 160 * DM * 2 / 16;
      for (int i = gt; i < 2 * PER; i += NGT) { const int s = i / PER, o = i % PER; *(u32x4*)(ws + WB_RKV + (size_t)(3 + s) * 8 * MiB + (size_t)96 * DM * 2 + (size_t)o * 16) = (u32x4){0u, 0u, 0u, 0u}; }
      for (int i = gt; i < 6144 * 64; i += NGT) { const int n = i >> 6, p = i & 63, blk = n >> 11;
          const bool dense = blk == 0 ? (p < 12) : (blk == 1 ? (p >= 12 && p < 24) : (p >= 24 && p < 56));
          if (!dense) *(u32x4*)(ws + WB_L2 + (size_t)n * 1024 + (size_t)p * 16) = (u32x4){0u, 0u, 0u, 0u}; } }
    { const float* w2 = a.in[15]; const float* a2 = a.in[18]; const float* g2 = a.in[20]; bf16_t* B2 = (bf16_t*)(ws + WB_L2);
      for (int it = gw; it < 14 * 64; it += NGW) { const int kbi = it >> 6, nb = it & 63;
          const float* src; int nrow0, kcol0;
          if (kbi < 3) { src = w2 + (size_t)(32 * kbi) * DM; nrow0 = 0; kcol0 = 32 * kbi; }
          else if (kbi < 6) { src = a2 + (size_t)(32 * (kbi - 3)) * DM; nrow0 = 2048; kcol0 = 96 + 32 * (kbi - 3); }
          else { src = g2 + (size_t)(32 * (kbi - 6)) * DM; nrow0 = 4096; kcol0 = 192 + 32 * (kbi - 6); }
          transpose_item32(src + 32 * nb, DM, B2 + (size_t)(nrow0 + 32 * nb) * 512 + kcol0, 512, scr, lane); } }
    if (do_mod) { float* mod = (float*)(ws + WS_CTL); const float* cvec = a.in[1];
      for (int it = gw; it < 16 * 16; it += NGW) mod_item(a.in[2], 12288, 16, a.in[3], cvec, (float*)(ws + WS_PART0), it, lane);
    }
}

__device__ __forceinline__ void phase_mix(const Args& a, LAS unsigned char* lds) {
    unsigned char* ws = launder(a.ws);
    const int tid = launder_tid(), lane = tid & 63, wave = tid >> 6;
    const int gw = blockIdx.x * 8 + wave, NGW = gridDim.x * 8;
    const float* x = a.in[0]; const float* gmix = a.in[4]; const float* mu = a.in[8];
    const float* mod0 = (const float*)(ws + WS_CTL);
    bf16_t* AX = (bf16_t*)(ws + WS_AX6); bf16_t* A2 = (bf16_t*)(ws + WS_A2);
    LAS float* M0 = (LAS float*)lds;
    { const float* P0 = (const float*)(ws + WS_PART0);
      for (int i = tid; i < 4096; i += 512) { f32x4 v = *(const f32x4*)(P0 + i * 4);
#pragma unroll 5
          for (int kc = 1; kc < 16; ++kc) v += *(const f32x4*)(P0 + (size_t)kc * 16384 + i * 4);
          *(LAS f32x4*)(M0 + i * 4) = v; }
      LAS float* MU_ = M0 + 16384; for (int i = tid; i < 6 * 512; i += 512) *(LAS f32x4*)(MU_ + i * 4) = *(const f32x4*)(mu + i * 4);
      LAS float* GM_ = M0 + 16384 + 6 * 2048; for (int i = tid; i < 512; i += 512) *(LAS f32x4*)(GM_ + i * 4) = *(const f32x4*)(gmix + i * 4);
      __syncthreads(); }
    const LAS float* MU = M0 + 16384; const LAS float* GM = M0 + 16384 + 6 * 2048;
    for (int item = gw; item < MTOK / 4; item += NGW) {
        const int row0 = item * 4, b = row0 / TT, t0 = row0 % TT;
        const LAS float* scp = M0 + b * 4096 + 2048 + lane * 4; const LAS float* shp = M0 + b * 4096 + lane * 4;
        f32x4 hp[8];
#pragma unroll
        for (int j = 0; j < 8; ++j) hp[j] = (f32x4){0.f, 0.f, 0.f, 0.f};
        for (int rr = (t0 == 0 ? 0 : -1); rr < 4; ++rr) {
            const int row = row0 + rr;
            f32x4 h[8]; float ss = 0.f;
#pragma unroll
            for (int j = 0; j < 8; ++j) { h[j] = *(const f32x4*)(x + (size_t)row * DM + j * 256 + lane * 4); ss += dot4(h[j], h[j]); }
            ss = allreduce64(ss); const float rstd = rsqrtf(ss * (1.0f / DM) + RMS_EPS);
#pragma unroll
            for (int j = 0; j < 8; ++j) { const f32x4 g = *(const LAS f32x4*)(GM + j * 256 + lane * 4), sc = *(const LAS f32x4*)(scp + j * 256), sh = *(const LAS f32x4*)(shp + j * 256); h[j] = (h[j] * rstd * g) * (1.0f + sc) + sh; }
            asm volatile("" ::: "memory");
            if (rr >= 0) {
#pragma unroll
                for (int q = 0; q < 6; ++q) { const int slot = (q == 0) ? 0 : (q == 1) ? 3 : (q == 2) ? 1 : (q == 3) ? 2 : q;
                    bf16_t* O = AX + (size_t)slot * MD + (size_t)row * DM + lane * 4;
#pragma unroll
                    for (int j = 0; j < 8; ++j) { const f32x4 m = *(const LAS f32x4*)(MU + q * DM + j * 256 + lane * 4); const f32x4 xv = h[j] + (hp[j] - h[j]) * m; *(u32x2*)(O + j * 256) = pack4(xv); }
                    asm volatile("" ::: "memory"); }
                if (lane < 16) *(u32x2*)(A2 + (size_t)row * 512 + 448 + lane * 4) = (u32x2){0u, 0u};
            }
#pragma unroll
            for (int j = 0; j < 8; ++j) hp[j] = h[j];
        }
    }
}

__device__ __forceinline__ float allreduce8(float v) { v += dppmov<0xB1>(v); v += dppmov<0x4E>(v); v += dppmov<0x141>(v); return v; }
__device__ __forceinline__ void phase_scan(const Args& a, LAS unsigned char* lds) {
    unsigned char* ws = launder(a.ws);
    const int tid = launder_tid();
    LAS float* L = (LAS float*)lds;
    constexpr int BUF = 5 * 2048 + 1024 + 64;
    const bf16_t* Rg = (const bf16_t*)(ws + WS_RKV); const bf16_t* Kg = Rg + MD; const bf16_t* Vg = Rg + 2 * MD;
    const float* DECg = (const float*)(ws + WS_DEC); const bf16_t* AAg = (const bf16_t*)(DECg + MD);
    float* Yg = (float*)(ws + WS_Y); float* BON = (float*)(ws + WS_BON);
#define SCAN_BAR() do { asm volatile("s_waitcnt lgkmcnt(0)" ::: "memory"); __builtin_amdgcn_s_barrier(); asm volatile("" ::: "memory"); } while (0)
    for (int item = blockIdx.x; item < 256; item += gridDim.x) {
        const int xcd = item & 7, jj = item >> 3, half = jj & 1, bh = xcd * 16 + (jj >> 1), b = bh >> 5, h = bh & 31;
        if (tid < 256) {
            const int row = tid >> 3, seg = (tid & 7) * 8, l8 = tid & 7;
            f32x2 s01 = {0.f, 0.f}, s23 = s01, s45 = s01, s67 = s01; float sa = 0.f;
#ifdef EXPA
            f32x2 d01 = {0.f, 0.f}, d23 = d01, d45 = d01, d67 = d01; float sad = 0.f, dsum = 0.f;
#endif
            SCAN_BAR();
            for (int c = 0; c < 64; ++c) {
                const LAS float* Bf = L + (c & 1) * BUF + seg; LAS float* Yb = L + 2 * BUF + (c & 1) * 1024; const LAS float* Vb = L + (c & 1) * BUF + 10240 + row; const LAS float* Sc = L + (c & 1) * BUF + 11264;
#define LD8(lo, hi, off) lo = *(const LAS f32x4*)(Bf + (off)); hi = *(const LAS f32x4*)(Bf + (off) + 4)
#define LO2(v) __builtin_shufflevector(v, v, 0, 1)
#define HI2(v) __builtin_shufflevector(v, v, 2, 3)
                f32x4 na, nb, ka, kb, ba, bb, ra, rb; float vv; f32x2 bk;
                { LD8(na, nb, 6144); LD8(ka, kb, 4096); LD8(ba, bb, 8192); LD8(ra, rb, 0); vv = Vb[0]; bk = *(const LAS f32x2*)(Sc); }
                for (int t = 0; t < 32; t += 4) {
                    float yp[4];
#pragma unroll
                    for (int j = 0; j < 4; ++j) {
                        const int to = (t + j + 1) * 64;
                        f32x4 na_, nb_, ka_, kb_, ba_, bb_, ra_, rb_;
                        LD8(na_, nb_, 6144 + to); LD8(ka_, kb_, 4096 + to); LD8(ba_, bb_, 8192 + to); LD8(ra_, rb_, to); const float vv_ = Vb[(t + j + 1) * 32];
                        const f32x2 bk_ = *(const LAS f32x2*)(Sc + (t + j + 1) * 2);
                        __builtin_amdgcn_sched_barrier(0);
                        f32x2 p = s01 * LO2(na), p2 = s23 * HI2(na); p = s45 * LO2(nb) + p; p2 = s67 * HI2(nb) + p2; p = p + p2;
                        const f32x2 vv2 = {vv, vv}, sa2 = {sa, sa};
                        const float base = sa * bk.x + vv * bk.y;
                        const float P = allreduce8(p.x + p.y);
                        s01 = vv2 * LO2(ka) + s01; s23 = vv2 * HI2(ka) + s23; s45 = vv2 * LO2(kb) + s45; s67 = vv2 * HI2(kb) + s67;
                        s01 = sa2 * LO2(ba) + s01; s23 = sa2 * HI2(ba) + s23; s45 = sa2 * LO2(bb) + s45; s67 = sa2 * HI2(bb) + s67;
                        sa = P + base;
                        f32x2 q = s01 * LO2(ra), q2 = s23 * HI2(ra); q = s45 * LO2(rb) + q; q2 = s67 * HI2(rb) + q2; q = q + q2;
                        yp[j] = q.x + q.y;
#ifdef EXPA
                        { f32x2 pd = d01 * LO2(na), pd2 = d23 * HI2(na); pd = d45 * LO2(nb) + pd; pd2 = d67 * HI2(nb) + pd2; pd = pd + pd2;
                          f32x2 u01 = vv2 * LO2(kb), u23 = vv2 * HI2(kb), u45 = vv2 * LO2(ka), u67 = vv2 * HI2(ka);
                          const float Pd = allreduce8(pd.x + pd.y); const f32x2 sd2 = {sad, sad};
                          u01 = sd2 * LO2(ba) + u01; u23 = sd2 * HI2(ba) + u23; u45 = sd2 * LO2(bb) + u45; u67 = sd2 * HI2(bb) + u67;
                          d01 = d01 * LO2(wa) + u01; d23 = d23 * HI2(wa) + u23; d45 = d45 * LO2(wb) + u45; d67 = d67 * HI2(wb) + u67;
                          sad = Pd + sad * bk.x;
                          f32x2 qd = d01 * LO2(ra), qd2 = d23 * HI2(ra); qd = d45 * LO2(rb) + qd; qd2 = d67 * HI2(rb) + qd2; qd = qd + qd2; dsum += allreduce8(qd.x + qd.y); }
#endif
#ifdef EXPB
                        { f32x4 x0, x1, x2, x3, x4, x5, x6, x7, x8, x9; const int tb = (t + j) * 64;
                          LD8(x0, x1, 6144 + tb); LD8(x2, x3, 4096 + tb); LD8(x4, x5, 8192 + tb); LD8(x6, x7, 2048 + tb); LD8(x8, x9, tb);
                          asm volatile("" :: "v"(x0), "v"(x1), "v"(x2), "v"(x3), "v"(x4), "v"(x5), "v"(x6), "v"(x7), "v"(x8), "v"(x9)); }
#endif
                        na = na_; nb = nb_; ka = ka_; kb = kb_; ba = ba_; bb = bb_; ra = ra_; rb = rb_; vv = vv_; bk = bk_;
                    }
#pragma unroll
                    for (int j = 0; j < 4; ++j) yp[j] = allreduce8(yp[j]);
                    const float yv = l8 == 0 ? yp[0] : (l8 == 1 ? yp[1] : (l8 == 2 ? yp[2] : yp[3]));
                    if (l8 < 4) Yb[(t + l8) * 32 + row] = yv;
                }
                { const f32x4 g0 = *(const LAS f32x4*)(Bf + 2048), g1 = *(const LAS f32x4*)(Bf + 2048 + 4);
                  s01 *= LO2(g0); s23 *= HI2(g0); s45 *= LO2(g1); s67 *= HI2(g1); }
#undef LO2
#undef HI2
#undef LD8
                SCAN_BAR();
            }
#ifdef EXPA
            asm volatile("" :: "v"(dsum));
#endif
        } else {
            const int lt = tid - 256, tl = lt >> 4, c4 = (lt & 15) * 4;
            const f32x4 kk4 = *(const f32x4*)(a.in[21] + h * 64 + c4), ka4 = *(const f32x4*)(a.in[22] + h * 64 + c4), rk4 = *(const f32x4*)(a.in[23] + h * 64 + c4);
            const size_t gbase = (size_t)(b * TT) * DM + h * 64 + c4;
            u32x2 prA0, pkA0, pvA0, paA0, pnA0, prA1, pkA1, pvA1, paA1, pnA1; f32x4 lwA0, lwA1;
#define SCAN_LOAD1(c, X, u) do { const size_t o_ = gbase + (size_t)((c) * 32 + tl + 16 * (u)) * DM; pr##X##u = *(const u32x2*)(Rg + o_); pk##X##u = *(const u32x2*)(Kg + o_); pv##X##u = ((c4 >> 5) == half) ? *(const u32x2*)(Vg + o_) : (u32x2){0u, 0u}; lw##X##u = *(const f32x4*)(DECg + o_); pa##X##u = *(const u32x2*)(AAg + o_); \
                pn##X##u = ((c) * 32 + tl + 16 * (u) + 1 < TT) ? *(const u32x2*)(Kg + o_ + DM) : (u32x2){0u, 0u}; } while (0)
#define SCAN_LOAD(c, X) do { SCAN_LOAD1(c, X, 0); SCAN_LOAD1(c, X, 1); } while (0)
#define SCAN_PREP1(c, X, u) do { LAS float* Bf_ = L + ((c) & 1) * BUF; const int tq = tl + 16 * (u); \
                const f32x4 lr##X##u = cvt4(pr##X##u), lk##X##u = cvt4(pk##X##u), lv##X##u = cvt4(pv##X##u), la##X##u = cvt4(pa##X##u), ln##X##u = cvt4(pn##X##u); \
                const f32x4 kkv = lk##X##u * kk4; float ss = allreduce16(dot4(kkv, kkv)); const float inv = fminf(__builtin_amdgcn_rsqf(ss), 1e12f); const f32x4 kkn = kkv * inv;     \
                const f32x4 kkv1 = ln##X##u * kk4; float ss1 = allreduce16(dot4(kkv1, kkv1)); const float inv1 = fminf(__builtin_amdgcn_rsqf(ss1), 1e12f); const f32x4 nn1 = -(kkv1 * inv1); \
                const f32x4 km = lk##X##u * (1.0f + (la##X##u - 1.0f) * ka4); const f32x4 bb = kkn * la##X##u; \
                if (half == 0) { const float bon = allreduce16(dot4(lr##X##u * km, rk4)); if ((lt & 15) == 0) BON[(size_t)(b * TT + (c) * 32 + tq) * 32 + h] = bon; }     \
                const float beta = allreduce16(dot4(bb, nn1)), kappa = allreduce16(dot4(km, nn1)); \
                const f32x4 G_ = lw##X##u; f32x4 iG_; iG_[0] = __builtin_amdgcn_rcpf(G_[0]); iG_[1] = __builtin_amdgcn_rcpf(G_[1]); iG_[2] = __builtin_amdgcn_rcpf(G_[2]); iG_[3] = __builtin_amdgcn_rcpf(G_[3]);     \
                *(LAS f32x4*)(Bf_ + tq * 64 + c4) = lr##X##u * G_; *(LAS f32x4*)(Bf_ + 4096 + tq * 64 + c4) = km * iG_; \
                *(LAS f32x4*)(Bf_ + 6144 + tq * 64 + c4) = G_ * nn1; *(LAS f32x4*)(Bf_ + 8192 + tq * 64 + c4) = bb * iG_; \
                if (tq == 31) *(LAS f32x4*)(Bf_ + 2048 + c4) = G_;     \
                if ((lt & 15) == 0) *(LAS f32x2*)(Bf_ + 11264 + tq * 2) = (f32x2){beta, kappa}; \
                if ((c4 >> 5) == half) *(LAS f32x4*)(Bf_ + 10240 + tq * 32 + (c4 & 31)) = lv##X##u; } while (0)
#define SCAN_PREP(c, X) do { SCAN_PREP1(c, X, 0); SCAN_PREP1(c, X, 1); } while (0)
#define SCAN_YOUT(c) do { const LAS float* Yb = L + 2 * BUF + ((c) & 1) * 1024; const int idx = lt * 4, t = idx >> 5, rw = idx & 31; const f32x4 v = *(const LAS f32x4*)(Yb + idx); \
                *(f32x4*)(Yg + (size_t)(b * TT + (c) * 32 + t) * DM + h * 64 + half * 32 + rw) = v; } while (0)
            const int lane = lt & 63, lw = __builtin_amdgcn_readfirstlane(lt >> 6); LAS float* scr = L + 2 * BUF + 2048 + lw * (64 * 33);
            f32x4 tq[8]; const float* tW; int tK, tN, tItem; bf16_t* tWT;
#define tv(i) tq[(i) >> 2][(i) & 3]
            const int mtask = item * 2 + lw; const bool domod = (lw < 2) && (item < 192);
            const int mkq = mtask & 3;
#define MOD_DECODE() const int cbg_ = mtask >> 2; const float* mW = cbg_ < 32 ? a.in[2] : (cbg_ < 80 ? a.in[2] + (size_t)DM * 12288 : a.in[29]); const int mN = cbg_ < 80 ? 12288 : 4096; \
            const int mcol = cbg_ < 32 ? (16 + cbg_) * 256 : (cbg_ < 80 ? (cbg_ - 32) * 256 : (cbg_ - 80) * 256);
#define LATER_BEGIN(c) const int widx_ = item < 192 ? item * 2 + (lw - 2) : 384 + (item - 192) * 4 + lw; const int slot_ = (c) * 640 + widx_; const bool do_ = !domod && slot_ < LATER_ITEMS; if (do_) { later_src(a, ws, slot_, tW, tK, tN, tWT, tItem); TR_LOAD(tv, tW, tN, tItem); }
#define LATER_END(c) if (do_) { TR_STORE(tv, tK, tN, tWT, scr, tItem); }
            const float* cvec = a.in[1];
            f32x4 m0 = {0.f, 0.f, 0.f, 0.f}, m1 = m0, m2 = m0, m3 = m0;
#define MOD_LOAD(c) if (domod) { MOD_DECODE() const float* p_ = mW + (size_t)(mkq * 512 + (c) * 8) * mN + mcol + lane * 4; _Pragma("unroll") for (int i_ = 0; i_ < 8; ++i_) tq[i_] = __builtin_nontemporal_load((const f32x4*)(p_ + (size_t)i_ * mN)); }
#define MOD_FMA(c) if (domod) { const int r_ = mkq * 512 + (c) * 8; _Pragma("unroll") for (int i_ = 0; i_ < 8; ++i_) { m0 += tq[i_] * cvec[r_ + i_]; m1 += tq[i_] * cvec[DM + r_ + i_]; m2 += tq[i_] * cvec[2 * DM + r_ + i_]; m3 += tq[i_] * cvec[3 * DM + r_ + i_]; } }
            SCAN_LOAD(0, A); SCAN_PREP(0, A); SCAN_LOAD(1, A); MOD_LOAD(0)
            SCAN_BAR();
            for (int c = 0; c < 64; ++c) {
                MOD_FMA(c)
                if (c + 1 < 64) SCAN_PREP(c + 1, A);
                LATER_BEGIN(c)
                if (c + 2 < 64) SCAN_LOAD(c + 2, A);
                if (c >= 1) SCAN_YOUT(c - 1);
                LATER_END(c)
                if (c + 1 < 64) { MOD_LOAD(c + 1) }
                SCAN_BAR();
            }
            if (domod) {
                MOD_DECODE() (void)mW; (void)mN; const float* mBias = cbg_ < 32 ? a.in[3] : (cbg_ < 80 ? a.in[3] + 12288 : a.in[30]);
                if (mkq == 0) { const f32x4 bv = *(const f32x4*)(mBias + mcol + lane * 4); m0 += bv; m1 += bv; m2 += bv; m3 += bv; }
                float* o_ = (float*)(ws + WS_PARTS) + (size_t)mtask * 1024 + lane * 4;
                *(f32x4*)(o_) = m0; *(f32x4*)(o_ + 256) = m1; *(f32x4*)(o_ + 512) = m2; *(f32x4*)(o_ + 768) = m3;
            }
#undef MOD_LOAD
#undef MOD_FMA
#undef MOD_DECODE
#undef tv
#undef LATER_BEGIN
#undef LATER_END
            SCAN_YOUT(63);
#undef SCAN_LOAD1
#undef SCAN_LOAD
#undef SCAN_PREP1
#undef SCAN_PREP
#undef SCAN_YOUT
        }
        __syncthreads();
    }
#undef SCAN_BAR
}

__device__ __forceinline__ void phase_gn(const Args& a, LAS unsigned char* lds) {
    unsigned char* ws = launder(a.ws);
    const int tid = launder_tid(), lane = tid & 63, wave = tid >> 6;
    const int gw = blockIdx.x * 8 + wave, NGW = gridDim.x * 8;
    const float* Yg = (const float*)(ws + WS_Y); const float* BON = (const float*)(ws + WS_BON);
    const bf16_t* Vg = (const bf16_t*)(ws + WS_RKV) + 2 * MD; const bf16_t* GG = (const bf16_t*)((const float*)(ws + WS_DEC) + MD) + MD;
    const float* lnw = a.in[24]; const float* lnb = a.in[25]; bf16_t* YG = (bf16_t*)(ws + WS_YG);
    { const float* PS = (const float*)(ws + WS_PARTS); float* mod = (float*)(ws + WS_CTL);
      for (int i = blockIdx.x * 512 + tid; i < 96 * 4 * 64; i += gridDim.x * 512) { const int l4 = i & 63, bq = (i >> 6) & 3, cbg = i >> 8;
          const float* p = PS + (size_t)(cbg * 4) * 1024 + bq * 256 + l4 * 4;
          const f32x4 v = ((*(const f32x4*)p + *(const f32x4*)(p + 1024)) + *(const f32x4*)(p + 2048)) + *(const f32x4*)(p + 3072);
          float* o = cbg < 32 ? mod + (size_t)bq * 12288 + (16 + cbg) * 256 : (cbg < 80 ? mod + 4 * 12288 + (size_t)bq * 12288 + (cbg - 32) * 256 : mod + 2 * 4 * 12288 + (size_t)bq * 4096 + (cbg - 80) * 256);
          *(f32x4*)(o + l4 * 4) = v; } }
    LAS float* LW = (LAS float*)lds; LAS float* LB = LW + 2048;
    for (int i = tid; i < 512; i += 512) { *(LAS f32x4*)(LW + i * 4) = *(const f32x4*)(lnw + i * 4); *(LAS f32x4*)(LB + i * 4) = *(const f32x4*)(lnb + i * 4); }
    __syncthreads();
    f32x4 yq[8]; u32x2 vq[8], gq[8]; float bq[8];
#define GN_LOAD(r_) _Pragma("unroll") for (int j = 0; j < 8; ++j) { const size_t o_ = (size_t)(r_) * DM + j * 256 + lane * 4; yq[j] = *(const f32x4*)(Yg + o_); vq[j] = *(const u32x2*)(Vg + o_); gq[j] = *(const u32x2*)(GG + o_); bq[j] = BON[(size_t)(r_) * 32 + j * 4 + (lane >> 4)]; }
    if (gw < MTOK) { GN_LOAD(gw) }
    for (int row = gw; row < MTOK; row += NGW) {
        f32x4 y[8], v[8], g[8]; float bn[8];
#pragma unroll
        for (int j = 0; j < 8; ++j) { y[j] = yq[j]; v[j] = cvt4(vq[j]); g[j] = cvt4(gq[j]); bn[j] = bq[j]; }
        if (row + NGW < MTOK) { GN_LOAD(row + NGW) }
#pragma unroll
        for (int j = 0; j < 8; ++j) { const int col = j * 256 + lane * 4; const size_t o = (size_t)row * DM + col;
            const float mean = allreduce16(sum4(y[j])) * (1.0f / 64.0f); const f32x4 d = y[j] - mean;
            const float var = allreduce16(dot4(d, d)) * (1.0f / 64.0f); const float rs = rsqrtf(var + GN_EPS);
            f32x4 yn = d * rs * *(const LAS f32x4*)(LW + col) + *(const LAS f32x4*)(LB + col);
            yn += v[j] * bn[j];
            *(u32x2*)(YG + o) = pack4(yn * g[j]); }
    }
#undef GN_LOAD
}

__device__ __forceinline__ void phase_norm(LAS unsigned char* lds, const void* X, const bool xf32, const float* gA, const float* scA, const float* shA, int strideA, bf16_t* outA,
                                           const float* gB, const float* scB, const float* shB, int strideB, bf16_t* outB, const float* gF, float* outF) {
    const int tid = launder_tid(), lane = tid & 63, wave = tid >> 6;
    const int gw = blockIdx.x * 8 + wave, NGW = gridDim.x * 8;
    LAS float* GA = (LAS float*)lds; LAS float* SA = GA + 8192; LAS float* GB = GA + 16384; LAS float* SB = GA + 24576; LAS float* GF = GA;
    if (outA) for (int i = tid; i < 2048; i += 512) { const int b = i >> 9, c = (i & 511) * 4; const f32x4 g = *(const f32x4*)(gA + c), sc = *(const f32x4*)(scA + (size_t)b * strideA + c);
        *(LAS f32x4*)(GA + b * 2048 + c) = g * (1.0f + sc); *(LAS f32x4*)(SA + b * 2048 + c) = *(const f32x4*)(shA + (size_t)b * strideA + c); }
    if (outB) for (int i = tid; i < 2048; i += 512) { const int b = i >> 9, c = (i & 511) * 4; const f32x4 g = *(const f32x4*)(gB + c), sc = *(const f32x4*)(scB + (size_t)b * strideB + c);
        *(LAS f32x4*)(GB + b * 2048 + c) = g * (1.0f + sc); *(LAS f32x4*)(SB + b * 2048 + c) = *(const f32x4*)(shB + (size_t)b * strideB + c); }
    if (outF) for (int i = tid; i < 512; i += 512) *(LAS f32x4*)(GF + i * 4) = *(const f32x4*)(gF + i * 4);
    __syncthreads();
    u32x2 xr[8]; f32x4 xq[8];
    if (gw < MTOK) {
#pragma unroll
        for (int j = 0; j < 8; ++j) { const size_t o_ = (size_t)gw * DM + j * 256 + lane * 4; if (xf32) xq[j] = *(const f32x4*)((const float*)X + o_); else xr[j] = *(const u32x2*)((const bf16_t*)X + o_); }
    }
    for (int row = gw; row < MTOK; row += NGW) {
        const int b = row / TT;
        f32x4 xv[8]; float ss = 0.f;
#pragma unroll
        for (int j = 0; j < 8; ++j) { xv[j] = xf32 ? xq[j] : cvt4(xr[j]); ss += dot4(xv[j], xv[j]); }
        if (row + NGW < MTOK) {
#pragma unroll
            for (int j = 0; j < 8; ++j) { const size_t o_ = (size_t)(row + NGW) * DM + j * 256 + lane * 4; if (xf32) xq[j] = *(const f32x4*)((const float*)X + o_); else xr[j] = *(const u32x2*)((const bf16_t*)X + o_); }
        }
        ss = allreduce64(ss); const float rstd = rsqrtf(ss * (1.0f / DM) + RMS_EPS);
        if (outA) {
#pragma unroll
            for (int j = 0; j < 8; ++j) { const int col = j * 256 + lane * 4;
                *(u32x2*)(outA + (size_t)row * DM + col) = pack4((xv[j] * rstd) * *(const LAS f32x4*)(GA + b * 2048 + col) + *(const LAS f32x4*)(SA + b * 2048 + col)); } }
        if (outB) {
#pragma unroll
            for (int j = 0; j < 8; ++j) { const int col = j * 256 + lane * 4;
                *(u32x2*)(outB + (size_t)row * DM + col) = pack4((xv[j] * rstd) * *(const LAS f32x4*)(GB + b * 2048 + col) + *(const LAS f32x4*)(SB + b * 2048 + col)); } }
        if (outF) {
#pragma unroll
            for (int j = 0; j < 8; ++j) { const int col = j * 256 + lane * 4; *(f32x4*)(outF + (size_t)row * DM + col) = xv[j] * rstd * *(const LAS f32x4*)(GF + col); } }
    }
    __syncthreads();
}

__device__ __forceinline__ void phase_attn(const Args& a, LAS unsigned char* lds) {
    unsigned char* ws = launder(a.ws);
    const int tid = launder_tid(), lane = tid & 63, wave = tid >> 6, r32 = lane & 31, hi = lane >> 5;
    LAS float* tab = (LAS float*)(lds + wave * 2304);
    const int gw = blockIdx.x * 8 + wave, NGW = gridDim.x * 8;
    const bf16_t* Kb = (const bf16_t*)(ws + WS_KB); const bf16_t* Vt = Kb + MD; const bf16_t* Qb = Kb + 2 * MD; bf16_t* Ob = (bf16_t*)(ws + WS_KB) + 3 * MD;
    const float* relb_g = a.in[28];
    const int pi = (r32 & ~12) | ((r32 & 4) << 1) | ((r32 & 8) >> 1);
    int cur_h = -1;
    for (int u = gw; u < 4096; u += NGW) {
        const int bh = u >> 5, n = u & 31, b = bh >> 5, h = bh & 31;
        if (h != cur_h) { for (int i = lane; i < 513; i += 64) tab[i] = relb_g[h * 513 + i] * LOG2E; cur_h = h; }
        const bf16_t* qbase = Qb + (size_t)(b * TT + n * 64) * DM + h * 64;
        bf16x8 qf[2][4];
#pragma unroll
        for (int qt = 0; qt < 2; ++qt)
#pragma unroll
            for (int kk = 0; kk < 4; ++kk) qf[qt][kk] = *(const bf16x8*)(qbase + (size_t)(qt * 32 + r32) * DM + kk * 16 + hi * 8);
        f32x16 ot[2][2];
#pragma unroll
        for (int i = 0; i < 2; ++i)
#pragma unroll
            for (int j = 0; j < 2; ++j)
#pragma unroll
                for (int r = 0; r < 16; ++r) ot[i][j][r] = 0.f;
        float mrow[2] = {-1e30f, -1e30f}, lrow[2] = {0.f, 0.f};
        const int jc0 = n < 8 ? 8 - n : 0;
        bf16x8 kf[4];
        { const bf16_t* kp = Kb + (size_t)(b * TT + n * 64 - 512 + jc0 * 64 + pi) * DM + h * 64 + hi * 8;
#pragma unroll
          for (int kk = 0; kk < 4; ++kk) kf[kk] = *(const bf16x8*)(kp + kk * 16); }
        for (int tile = jc0 * 2; tile < 18; ++tile) {
            const int kt0 = n * 64 - 512 + tile * 32;
            const bf16_t* vp = Vt + (size_t)(b * 2048 + h * 64 + r32) * 2048 + kt0 + hi * 8;
            bf16x8 vf[2][2];
#pragma unroll
            for (int dt = 0; dt < 2; ++dt)
#pragma unroll
                for (int mm = 0; mm < 2; ++mm) vf[dt][mm] = *(const bf16x8*)(vp + (size_t)dt * 32 * 2048 + mm * 16);
            f32x16 st[2];
#pragma unroll
            for (int qt = 0; qt < 2; ++qt) {
#pragma unroll
                for (int r = 0; r < 16; ++r) st[qt][r] = 0.f;
#pragma unroll
                for (int kk = 0; kk < 4; ++kk) st[qt] = __builtin_amdgcn_mfma_f32_32x32x16_bf16(kf[kk], qf[qt][kk], st[qt], 0, 0, 0);
            }
            if (tile + 1 < 18) { const bf16_t* kp = Kb + (size_t)(b * TT + kt0 + 32 + pi) * DM + h * 64 + hi * 8;
#pragma unroll
                for (int kk = 0; kk < 4; ++kk) kf[kk] = *(const bf16x8*)(kp + kk * 16); }
            const int relb = n * 64 + r32 - kt0 - 8 * hi;
            const bool far = (n * 64 - kt0 - 31) >= 256;
            const float bfar = tab[512];
#pragma unroll
            for (int qt = 0; qt < 2; ++qt) {
                float mx = -1e30f;
                if (far) {
#pragma unroll
                    for (int r = 0; r < 16; ++r) { const float sv = st[qt][r] + bfar; st[qt][r] = sv; mx = fmaxf(mx, sv); }
                } else {
#pragma unroll
                    for (int r = 0; r < 16; ++r) { int rel = relb + qt * 32 - (16 * (r >> 3) + (r & 7)); rel = rel < -256 ? -256 : (rel > 256 ? 256 : rel); const float sv = st[qt][r] + tab[rel + 256]; st[qt][r] = sv; mx = fmaxf(mx, sv); }
                }
                mx = fmaxf(mx, __shfl_xor(mx, 32));
                const float mnew = fmaxf(mrow[qt], mx);
                if (__any(mnew > mrow[qt])) {
                    const float alpha = __builtin_amdgcn_exp2f(mrow[qt] - mnew); mrow[qt] = mnew; lrow[qt] *= alpha;
#pragma unroll
                    for (int dt = 0; dt < 2; ++dt)
#pragma unroll
                        for (int r = 0; r < 16; ++r) ot[dt][qt][r] *= alpha;
                }
                float ps = 0.f;
#pragma unroll
                for (int r = 0; r < 16; ++r) { const float p = __builtin_amdgcn_exp2f(st[qt][r] - mnew); st[qt][r] = p; ps += p; }
                lrow[qt] += ps;
            }
#pragma unroll
            for (int qt = 0; qt < 2; ++qt)
#pragma unroll
                for (int mm = 0; mm < 2; ++mm) {
                    u32x4 pw; pw.x = cvt_pk_bf16(st[qt][8 * mm + 0], st[qt][8 * mm + 1]); pw.y = cvt_pk_bf16(st[qt][8 * mm + 2], st[qt][8 * mm + 3]);
                    pw.z = cvt_pk_bf16(st[qt][8 * mm + 4], st[qt][8 * mm + 5]); pw.w = cvt_pk_bf16(st[qt][8 * mm + 6], st[qt][8 * mm + 7]);
                    const bf16x8 pb = __builtin_bit_cast(bf16x8, pw);
#pragma unroll
                    for (int dt = 0; dt < 2; ++dt) ot[dt][qt] = __builtin_amdgcn_mfma_f32_32x32x16_bf16(vf[dt][mm], pb, ot[dt][qt], 0, 0, 0);
                }
        }
#pragma unroll
        for (int qt = 0; qt < 2; ++qt) {
            const float l = lrow[qt] + __shfl_xor(lrow[qt], 32); const float inv = 1.0f / l;
            bf16_t* O = Ob + (size_t)(b * TT + n * 64 + qt * 32 + r32) * DM + h * 64 + 4 * hi;
#pragma unroll
            for (int dt = 0; dt < 2; ++dt)
#pragma unroll
                for (int g = 0; g < 4; ++g) { f32x4 o = {ot[dt][qt][4 * g] * inv, ot[dt][qt][4 * g + 1] * inv, ot[dt][qt][4 * g + 2] * inv, ot[dt][qt][4 * g + 3] * inv}; *(u32x2*)(O + dt * 32 + 8 * g) = pack4(o); }
        }
    }
}

#define XB_TMO      128
#define XB_XCNT(j)  (256  + 64 * (j))
#define XB_XSUB(j)  (1280 + 64 * (j))
#define XB_XGEN(j)  (2304 + 64 * (j))
#define XB_TOP      3328
#define XB_TOPGEN   3392
#define XCD_BAR_WORDS 3456
#define XB_SPIN_CAP (1u << 18)
__device__ __forceinline__ unsigned xb_ld(unsigned* p)              { return __hip_atomic_load(p, __ATOMIC_RELAXED, __HIP_MEMORY_SCOPE_AGENT); }
__device__ __forceinline__ unsigned xb_add(unsigned* p, unsigned v) { return __hip_atomic_fetch_add(p, v, __ATOMIC_RELAXED, __HIP_MEMORY_SCOPE_AGENT); }
__device__ __forceinline__ unsigned xb_xcc_id() { return (unsigned)__builtin_amdgcn_s_getreg((3 << 11) | 20) & 0xFu; }
#define XB_SPIN(cond, bar) do { unsigned _sp = 0; while (cond) { __builtin_amdgcn_s_sleep(1); \
    if ((++_sp & 255u) == 0u) { if (xb_ld(&(bar)[XB_TMO])) break; if (_sp > XB_SPIN_CAP) { atomicAdd(&(bar)[XB_TMO], 1u); break; } } } } while (0)
struct XcdBarrier { unsigned* bar; unsigned x; volatile LAS unsigned* st; };
__device__ __forceinline__ XcdBarrier xcd_barrier_post(unsigned* bar, volatile LAS unsigned* st) {
    XcdBarrier b; b.bar = bar; b.x = xb_xcc_id(); b.st = st;
    if (threadIdx.x == 0) (void)xb_add(&bar[XB_XCNT(b.x)], 1u);
    return b;
}
__device__ __forceinline__ void xcd_barrier_complete(unsigned* bar, unsigned x, unsigned& nloc, unsigned& nx) {
    const unsigned G = gridDim.x * gridDim.y * gridDim.z;
    unsigned sum, cnt, mine, sp = 0u;
    for (;;) {
        sum = 0u; cnt = 0u; mine = 0u;
#pragma unroll
        for (unsigned j = 0; j < 16; ++j) { const unsigned c = xb_ld(&bar[XB_XCNT(j)]); sum += c; cnt += (c > 0u) ? 1u : 0u; mine = (j == x) ? c : mine; }
        if (sum == G) break;
        __builtin_amdgcn_s_sleep(1);
        if ((++sp & 255u) == 0u) { if (xb_ld(&bar[XB_TMO])) break; if (sp > XB_SPIN_CAP) { atomicAdd(&bar[XB_TMO], 1u); break; } }
    }
    nloc = mine > 0u ? mine : 1u; nx = cnt > 0u ? cnt : 1u;
}
__device__ __forceinline__ void xcd_barrier(const XcdBarrier& b) {
    asm volatile("s_waitcnt vmcnt(0)" ::: "memory");
    __syncthreads();
    if (threadIdx.x == 0) {
        unsigned* bar = b.bar;
        __builtin_amdgcn_s_waitcnt(0);
        unsigned nloc = b.st[0], nx = b.st[1];
        if (nloc == 0u) { xcd_barrier_complete(bar, b.x, nloc, nx); b.st[0] = nloc; b.st[1] = nx; }
        const unsigned old = xb_add(&bar[XB_XSUB(b.x)], 1u);
        const unsigned gen = old / nloc;
        if (old + 1u == (gen + 1u) * nloc) {
            __builtin_amdgcn_fence(__ATOMIC_RELEASE, "agent");
            asm volatile("s_waitcnt vmcnt(0)" ::: "memory");
            const unsigned og = xb_add(&bar[XB_TOP], 1u);
            const unsigned tg = og / nx;
            if (og + 1u == (tg + 1u) * nx) xb_add(&bar[XB_TOPGEN], 1u);
            else XB_SPIN(xb_ld(&bar[XB_TOPGEN]) == tg, bar);
            __builtin_amdgcn_fence(__ATOMIC_ACQUIRE, "agent");
            xb_add(&bar[XB_XGEN(b.x)], 1u);
            asm volatile("s_waitcnt vmcnt(0)" ::: "memory");
        } else {
            XB_SPIN(xb_ld(&bar[XB_XGEN(b.x)]) == gen, bar);
            __builtin_amdgcn_fence(__ATOMIC_ACQUIRE, "agent");
            asm volatile("s_waitcnt vmcnt(0)" ::: "memory");
        }
    }
    __syncthreads();
}

__global__ void __launch_bounds__(512, 2) fwd_megakernel(Args a) {
    extern __shared__ __attribute__((aligned(16))) unsigned char lds_raw[];
    LAS unsigned char* lds = (LAS unsigned char*)lds_raw;
    cg::grid_group grid = cg::this_grid();
    const int G = gridDim.x, cidx = blockIdx.x;
    if (threadIdx.x < 64) ((LAS unsigned*)(lds + LDS_BYTES - 256))[threadIdx.x] = 0u;
    __syncthreads();
    const XcdBarrier bar = xcd_barrier_post((unsigned*)(a.ws + WS_BAR), (volatile LAS unsigned*)(lds + LDS_BYTES - 256));
#ifndef PHM
#define PHM 0xFFFF
#endif
#define ON(k) ((PHM >> (k)) & 1)
#ifndef REPM
#define REPM 0
#endif
#define REP(k) for (int rep_ = 0; rep_ < 1 + ((REPM >> (k)) & 1); ++rep_)
#define GSYNC() do { xcd_barrier(bar); if ((REPM >> 14) & 1) xcd_barrier(bar); } while (0)
    REP(0) if (ON(0)) phase0(a, lds, rep_ == 0);
    if (a.ws == nullptr) grid.sync();
    GSYNC();
    REP(1) if (ON(1)) phase_mix(a, lds);
    GSYNC();
    REP(2) if (ON(2)) { unsigned char* ws = launder(a.ws); SchedP2 S{(const char*)(ws + WS_AX6), (const char*)(ws + WB_RKV), G, cidx}; EpiP2 E{(bf16_t*)(ws + WS_RKV), (bf16_t*)(ws + WS_A2)};
      pg8::gemm_phase(lds, DM, DM, S, E); }
    GSYNC();
    REP(3) if (ON(3)) { unsigned char* ws = launder(a.ws); EpiP3 E{(float*)(ws + WS_DEC), a.in[13], a.in[16], 0};
      { SchedSimple S{(const char*)(ws + WS_A2), (const char*)(ws + WB_L2), 32, 8, (size_t)256 * 512 * 2, G, cidx}; E.kind = 0; pg8::gemm_phase(lds, 128, 512, S, E); }
      { SchedSimple S{(const char*)(ws + WS_A2) + 64 * 2, (const char*)(ws + WB_L2) + (size_t)2048 * 512 * 2 + 64 * 2, 32, 8, (size_t)256 * 512 * 2, G, cidx}; E.kind = 1; pg8::gemm_phase(lds, 128, 512, S, E); }
      { SchedSimple S{(const char*)(ws + WS_A2) + 192 * 2, (const char*)(ws + WB_L2) + (size_t)4096 * 512 * 2 + 192 * 2, 32, 8, (size_t)256 * 512 * 2, G, cidx}; E.kind = 2; pg8::gemm_phase(lds, 256, 512, S, E); } }
    GSYNC();
    REP(4) if (ON(4)) phase_scan(a, lds);
    GSYNC();
    REP(5) if (ON(5)) phase_gn(a, lds);
    GSYNC();
    for (int l = 0; l < 2; ++l) {
        if (l == 1) {
            REP(6) if (ON(6)) { unsigned char* ws = launder(a.ws); const float* mod1 = (const float*)(ws + WS_CTL) + 4 * 12288; const float* modkv = mod1 + 4 * 12288;
              phase_norm(lds, (const void*)(ws + WS_X2), false, a.in[31], modkv + 2048, modkv, 4096, (bf16_t*)(ws + WS_Y), a.in[4] + DM, mod1 + 2048, mod1, 12288, (bf16_t*)(ws + WS_Y) + MD, nullptr, nullptr); }
            GSYNC();
            REP(7) if (ON(7)) { unsigned char* ws = launder(a.ws); SchedP11 S{(const char*)(ws + WS_Y), (const char*)(ws + WS_Y) + MD * 2, (const char*)(ws + WB_KVQ), G, cidx}; EpiP11 E{(bf16_t*)(ws + WS_KB)};
              pg8::gemm_phase(lds, DM, DM, S, E); }
            GSYNC();
            REP(8) if (ON(8)) phase_attn(a, lds);
            GSYNC();
        }
        REP(9) if (ON(9)) { unsigned char* ws = launder(a.ws); const float* mod = (const float*)(ws + WS_CTL) + (size_t)l * 4 * 12288; const void* xin = l == 0 ? (const void*)a.in[0] : (const void*)(ws + WS_X2);
          const char* Ain = l == 0 ? (const char*)(ws + WS_YG) : (const char*)(ws + WS_KB) + 3 * MD * 2; const char* Bin = l == 0 ? (const char*)(ws + WB_O) : (const char*)(ws + WB_AO);
          SchedSimple S{Ain, Bin, 32, 8, (size_t)256 * DM * 2, G, cidx}; EpiRes E{xin, l == 0 ? 1 : 0, mod + 4096, (void*)(ws + WS_X1), 0};
          pg8::gemm_phase(lds, DM, DM, S, E); }
        GSYNC();
        REP(10) if (ON(10)) { unsigned char* ws = launder(a.ws); const float* mod = (const float*)(ws + WS_CTL) + (size_t)l * 4 * 12288;
          phase_norm(lds, (const void*)(ws + WS_X1), false, a.in[5] + l * DM, mod + 8192, mod + 6144, 12288, (bf16_t*)(ws + WS_H2), nullptr, nullptr, nullptr, 0, nullptr, nullptr, nullptr); }
        GSYNC();
        REP(11) if (ON(11)) { unsigned char* ws = launder(a.ws); SchedSimple S{(const char*)(ws + WS_H2), (const char*)(ws + WB_UP + (size_t)l * 32 * MiB), 32, 32, (size_t)256 * DM * 2, G, cidx}; EpiUp E{(bf16_t*)(ws + WS_U)};
          pg8::gemm_phase(lds, DM, DM, S, E); }
        GSYNC();
        REP(12) if (ON(12)) { unsigned char* ws = launder(a.ws); const float* mod = (const float*)(ws + WS_CTL) + (size_t)l * 4 * 12288;
          SchedSimple S{(const char*)(ws + WS_U), (const char*)(ws + WB_DN + (size_t)l * 32 * MiB), 32, 8, (size_t)256 * FF * 2, G, cidx}; EpiRes E{(const void*)(ws + WS_X1), 0, mod + 10240, (void*)(ws + WS_X2), 0};
          pg8::gemm_phase(lds, FF, FF, S, E); }
        GSYNC();
    }
    REP(13) if (ON(13)) { unsigned char* ws = launder(a.ws); phase_norm(lds, (const void*)(ws + WS_X2), false, nullptr, nullptr, nullptr, 0, nullptr, nullptr, nullptr, nullptr, 0, nullptr, a.in[34], a.out); }
}

extern "C" void kernel_launch(void* const* d_in, const int* in_sizes, int n_in, void* d_out, int out_size, void* d_ws, size_t ws_size, hipStream_t stream) {
    static int grid = 0;
    if (grid == 0) {
        if (n_in != 35 || ws_size < WS_END) { fprintf(stderr, "kernel_launch: unexpected n_in %d / ws %zu\n", n_in, ws_size); grid = -1; return; }
        int dev = 0, cus = 0, per_cu = 0;
        hipGetDevice(&dev); hipDeviceGetAttribute(&cus, hipDeviceAttributeMultiprocessorCount, dev);
        hipFuncSetAttribute((const void*)fwd_megakernel, hipFuncAttributeMaxDynamicSharedMemorySize, LDS_BYTES);
        hipOccupancyMaxActiveBlocksPerMultiprocessor(&per_cu, (const void*)fwd_megakernel, 512, LDS_BYTES);
        if (per_cu < 1) { fprintf(stderr, "kernel_launch: occupancy query says %d blocks/CU\n", per_cu); per_cu = 1; }
        (void)hipGetLastError();
        grid = cus;
    }
    if (grid < 0) return;
    hipMemsetAsync((char*)d_ws + WS_BAR, 0, 16384, stream);
    Args a{};
    for (int i = 0; i < 35; ++i) a.in[i] = (const float*)d_in[i];
    a.out = (float*)d_out; a.ws = (unsigned char*)d_ws;
    void* args[] = {&a};
    hipError_t e = hipLaunchCooperativeKernel((const void*)fwd_megakernel, dim3(grid), dim3(512), args, LDS_BYTES, stream);
    if (e != hipSuccess) fprintf(stderr, "cooperative launch failed: %s (grid %d)\n", hipGetErrorString(e), grid);
}
```
